# Optimizing an MI355X kernel written in HIP

```python
import math
import jax
import jax.numpy as jnp
from jax import lax
import numpy as np

D_MODEL = 1024
BATCH = 4
SEQ = 8192
DEPTH = 1

N_MEM = 256
Q_BLOCK = 128
RMS_EPS = 1e-6
NEG_INF = -1e30
ROPE_THETA = 10000.0
POS_OFFSET_MAX = 1024

DIFF_HEADS = 8
DIFF_HALF_DIM = 32
DIFF_V_DIM = 2 * DIFF_HALF_DIM
DIFF_QK_WIDTH = DIFF_HEADS * 2 * DIFF_HALF_DIM
DIFF_WIDTH = DIFF_HEADS * DIFF_V_DIM

MLA_HEADS = 8
MLA_Q_RANK = 256
MLA_KV_RANK = 128
MLA_NOPE_DIM = 64
MLA_ROPE_DIM = 32
MLA_QK_DIM = MLA_NOPE_DIM + MLA_ROPE_DIM
MLA_V_DIM = 64
MLA_WIDTH = MLA_HEADS * MLA_V_DIM

MIX_WIDTH = DIFF_WIDTH + MLA_WIDTH
IN_SPLITS = (DIFF_QK_WIDTH,
             2 * DIFF_QK_WIDTH,
             2 * DIFF_QK_WIDTH + DIFF_WIDTH,
             2 * DIFF_QK_WIDTH + DIFF_WIDTH + MLA_Q_RANK,
             2 * DIFF_QK_WIDTH + DIFF_WIDTH + MLA_Q_RANK + MLA_KV_RANK)
IN_PROJ_WIDTH = IN_SPLITS[-1] + MLA_ROPE_DIM

MEM_HEADS = 4
MEM_HEAD_DIM = 128
MEM_WIDTH = MEM_HEADS * MEM_HEAD_DIM

N_GROUPS = 4
EXPERTS_PER_GROUP = 8
N_EXPERTS = N_GROUPS * EXPERTS_PER_GROUP
TOP_K_IN_GROUP = 2
EXPERT_FF = 256
EXPERT_BLOCK = 128

kernel_name = 'hybrid_diffattn_mla_hier_moe'


def _rms_norm(x, gain):
    xf = x.astype(jnp.float32)
    y = xf * lax.rsqrt(jnp.mean(xf * xf, axis=-1, keepdims=True) + RMS_EPS)
    return (y * gain.astype(jnp.float32)).astype(x.dtype)


def _alibi_slopes(n_heads):
    return 2.0 ** (-8.0 * jnp.arange(1, n_heads + 1, dtype=jnp.float32) / n_heads)


def _rope_angles(positions, dim):
    inv_freq = ROPE_THETA ** (-jnp.arange(0, dim, 2, dtype=jnp.float32) / dim)
    ang = positions.astype(jnp.float32)[..., None] * inv_freq
    return jnp.cos(ang), jnp.sin(ang)


def _apply_rope(x, cos, sin):
    half = x.shape[-1] // 2
    x1 = x[..., :half].astype(jnp.float32)
    x2 = x[..., half:].astype(jnp.float32)
    return jnp.concatenate([x1 * cos - x2 * sin, x2 * cos + x1 * sin], axis=-1).astype(x.dtype)


def _causal_mask(start, seq_len):
    q_idx = start + jnp.arange(Q_BLOCK)
    k_idx = jnp.arange(seq_len)
    return k_idx[None, :] <= q_idx[:, None]


def _query_block_sweep(block_fn, seq_len):
    n_blocks = seq_len // Q_BLOCK
    out = lax.map(block_fn, jnp.arange(n_blocks))
    nb, b, qb, w = out.shape
    return out.transpose(1, 0, 2, 3).reshape(b, nb * qb, w)


def _differential_attention(q, k, v, positions, lam, lambda_init, out_gain):
    b, s, h, _ = q.shape
    q = q.transpose(0, 2, 1, 3)
    k = k.transpose(0, 2, 1, 3)
    v = v.transpose(0, 2, 1, 3)
    q1, q2 = q[..., :DIFF_HALF_DIM], q[..., DIFF_HALF_DIM:]
    k1, k2 = k[..., :DIFF_HALF_DIM], k[..., DIFF_HALF_DIM:]
    slopes = _alibi_slopes(h)
    scale = DIFF_HALF_DIM ** -0.5
    pos_f = positions.astype(jnp.float32)
    gain = out_gain.astype(jnp.float32) * (1.0 - lambda_init)

    def block_fn(i):
        start = i * Q_BLOCK
        qb1 = lax.dynamic_slice_in_dim(q1, start, Q_BLOCK, axis=2)
        qb2 = lax.dynamic_slice_in_dim(q2, start, Q_BLOCK, axis=2)
        pos_q = lax.dynamic_slice_in_dim(pos_f, start, Q_BLOCK, axis=1)
        dist = jnp.abs(pos_q[:, :, None] - pos_f[:, None, :])
        bias = -slopes[None, :, None, None] * dist[:, None]
        mask = _causal_mask(start, s)

        def attn_map(qb, kk):
            sc = jnp.einsum('bhqd,bhkd->bhqk', qb, kk, preferred_element_type=jnp.float32) * scale + bias
            return jax.nn.softmax(jnp.where(mask, sc, NEG_INF), axis=-1)

        a = attn_map(qb1, k1) - lam * attn_map(qb2, k2)
        o = jnp.einsum('bhqk,bhkd->bhqd', a.astype(v.dtype), v, preferred_element_type=jnp.float32)
        o = o * lax.rsqrt(jnp.mean(o * o, axis=-1, keepdims=True) + RMS_EPS) * gain
        return o.transpose(0, 2, 1, 3).reshape(b, Q_BLOCK, h * DIFF_V_DIM).astype(v.dtype)

    return _query_block_sweep(block_fn, s)


def _latent_attention(q, k, v):
    b, s, h, _ = q.shape
    q = q.transpose(0, 2, 1, 3)
    k = k.transpose(0, 2, 1, 3)
    v = v.transpose(0, 2, 1, 3)
    scale = MLA_QK_DIM ** -0.5

    def block_fn(i):
        start = i * Q_BLOCK
        qb = lax.dynamic_slice_in_dim(q, start, Q_BLOCK, axis=2)
        sc = jnp.einsum('bhqd,bhkd->bhqk', qb, k, preferred_element_type=jnp.float32) * scale
        p = jax.nn.softmax(jnp.where(_causal_mask(start, s), sc, NEG_INF), axis=-1)
        o = jnp.einsum('bhqk,bhkd->bhqd', p.astype(v.dtype), v, preferred_element_type=jnp.float32)
        return o.transpose(0, 2, 1, 3).reshape(b, Q_BLOCK, h * MLA_V_DIM).astype(v.dtype)

    return _query_block_sweep(block_fn, s)


def _memory_cross_attention(h, mem_n, w_q, w_kv, w_o):
    b, s, _ = h.shape
    n_mem = mem_n.shape[1]
    q = (h @ w_q).reshape(b, s, MEM_HEADS, MEM_HEAD_DIM)
    kv = (mem_n @ w_kv).reshape(b, n_mem, 2, MEM_HEADS, MEM_HEAD_DIM)
    k, v = kv[:, :, 0], kv[:, :, 1]
    sc = jnp.einsum('bshd,bmhd->bhsm', q, k, preferred_element_type=jnp.float32) * MEM_HEAD_DIM ** -0.5
    p = jax.nn.softmax(sc, axis=-1)
    o = jnp.einsum('bhsm,bmhd->bshd', p.astype(v.dtype), v).reshape(b, s, MEM_WIDTH)
    return o @ w_o


def _hierarchical_moe(h, w_group_router, b_group_router, w_expert_router, b_expert_router,
                      w_gate, w_up, w_down):
    b, s, d = h.shape
    n_tok = b * s
    hf = h.reshape(n_tok, d)
    g_logits = jnp.einsum('td,dg->tg', hf, w_group_router, preferred_element_type=jnp.float32) \
        + b_group_router.astype(jnp.float32)
    g_probs = jax.nn.softmax(g_logits, axis=-1)
    g_gate, g_sel = lax.top_k(g_probs, 1)
    e_logits = jnp.einsum('td,de->te', hf, w_expert_router, preferred_element_type=jnp.float32) \
        + b_expert_router.astype(jnp.float32)
    e_logits = e_logits.reshape(n_tok, N_GROUPS, EXPERTS_PER_GROUP)
    e_logits = jnp.take_along_axis(e_logits, g_sel[:, :, None], axis=1)[:, 0]
    e_probs = jax.nn.softmax(e_logits, axis=-1)
    e_gate, e_sel = lax.top_k(e_probs, TOP_K_IN_GROUP)
    e_gate = e_gate / jnp.sum(e_gate, axis=-1, keepdims=True)
    weights = (g_gate * e_gate).reshape(-1)
    expert_ids = (g_sel * EXPERTS_PER_GROUP + e_sel).reshape(-1)
    token_ids = jnp.repeat(jnp.arange(n_tok, dtype=jnp.int32), TOP_K_IN_GROUP)

    n_assign = n_tok * TOP_K_IN_GROUP
    n_blocks = -(-(n_assign + N_EXPERTS * (EXPERT_BLOCK - 1)) // EXPERT_BLOCK)
    n_slots = n_blocks * EXPERT_BLOCK
    order = jnp.argsort(expert_ids)
    sorted_e = expert_ids[order]
    counts = jnp.bincount(expert_ids, length=N_EXPERTS)
    padded = ((counts + EXPERT_BLOCK - 1) // EXPERT_BLOCK) * EXPERT_BLOCK
    seg_start = jnp.cumsum(counts) - counts
    padded_end = jnp.cumsum(padded)
    padded_start = padded_end - padded
    dest = padded_start[sorted_e] + (jnp.arange(n_assign) - seg_start[sorted_e])
    slot_token = jnp.full((n_slots,), n_tok, jnp.int32).at[dest].set(token_ids[order])
    slot_weight = jnp.zeros((n_slots,), jnp.float32).at[dest].set(weights[order])
    block_expert = jnp.minimum(
        jnp.searchsorted(padded_end, jnp.arange(n_blocks) * EXPERT_BLOCK, side='right'), N_EXPERTS - 1)
    h_pad = jnp.concatenate([hf, jnp.zeros((1, d), hf.dtype)], axis=0)

    def block_fn(args):
        tok, wt, e = args
        xb = h_pad[tok]
        hidden = jax.nn.silu(xb @ w_gate[e]) * (xb @ w_up[e])
        return (hidden @ w_down[e]) * wt[:, None].astype(hf.dtype)

    y = lax.map(block_fn, (slot_token.reshape(n_blocks, EXPERT_BLOCK),
                           slot_weight.reshape(n_blocks, EXPERT_BLOCK),
                           block_expert))
    out = jnp.zeros((n_tok + 1, d), hf.dtype).at[slot_token].add(y.reshape(n_slots, d))[:n_tok]
    return out.reshape(b, s, d)


def setup_inputs(seed: int = 0) -> dict:
    key = jax.random.key(seed)
    ks = jax.random.split(key, 30)

    def w(k, shape, fan_in):
        return jax.random.normal(k, shape, jnp.float32) * fan_in ** -0.5

    def gain(k, shape):
        return 1.0 + 0.02 * jax.random.normal(k, shape, jnp.float32)

    x = jax.random.normal(ks[0], (BATCH, SEQ, D_MODEL), jnp.float32)
    mem = jax.random.normal(ks[1], (BATCH, N_MEM, D_MODEL), jnp.float32)
    offset = jax.random.randint(ks[2], (BATCH, 1), 0, POS_OFFSET_MAX, jnp.int32)
    positions = (offset + jnp.arange(SEQ, dtype=jnp.int32)[None, :]).astype(jnp.int32)
    return {
        'x': x,
        'mem': mem,
        'positions': positions,
        'norm_mix_g': gain(ks[3], (DEPTH, D_MODEL)),
        'w_in': w(ks[4], (DEPTH, D_MODEL, IN_PROJ_WIDTH), D_MODEL),
        'diff_lambda_q1': 0.1 * jax.random.normal(ks[5], (DEPTH, DIFF_HALF_DIM), jnp.float32),
        'diff_lambda_k1': 0.1 * jax.random.normal(ks[6], (DEPTH, DIFF_HALF_DIM), jnp.float32),
        'diff_lambda_q2': 0.1 * jax.random.normal(ks[7], (DEPTH, DIFF_HALF_DIM), jnp.float32),
        'diff_lambda_k2': 0.1 * jax.random.normal(ks[8], (DEPTH, DIFF_HALF_DIM), jnp.float32),
        'diff_out_g': gain(ks[9], (DEPTH, DIFF_V_DIM)),
        'mla_q_norm_g': gain(ks[10], (DEPTH, MLA_Q_RANK)),
        'w_mla_uq': w(ks[11], (DEPTH, MLA_Q_RANK, MLA_HEADS * MLA_QK_DIM), MLA_Q_RANK),
        'mla_kv_norm_g': gain(ks[12], (DEPTH, MLA_KV_RANK)),
        'w_mla_ukv': w(ks[13], (DEPTH, MLA_KV_RANK, MLA_HEADS * (MLA_NOPE_DIM + MLA_V_DIM)), MLA_KV_RANK),
        'mla_out_g': gain(ks[14], (DEPTH, MLA_WIDTH)),
        'w_out': w(ks[15], (DEPTH, MIX_WIDTH, D_MODEL), MIX_WIDTH),
        'norm_cross_g': gain(ks[16], (DEPTH, D_MODEL)),
        'norm_mem_g': gain(ks[17], (DEPTH, D_MODEL)),
        'w_mem_q': w(ks[18], (DEPTH, D_MODEL, MEM_WIDTH), D_MODEL),
        'w_mem_kv': w(ks[19], (DEPTH, D_MODEL, 2 * MEM_WIDTH), D_MODEL),
        'w_mem_o': w(ks[20], (DEPTH, MEM_WIDTH, D_MODEL), MEM_WIDTH),
        'norm_ffn_g': gain(ks[21], (DEPTH, D_MODEL)),
        'w_group_router': w(ks[22], (DEPTH, D_MODEL, N_GROUPS), D_MODEL),
        'b_group_router': 0.01 * jax.random.normal(ks[23], (DEPTH, N_GROUPS), jnp.float32),
        'w_expert_router': w(ks[24], (DEPTH, D_MODEL, N_EXPERTS), D_MODEL),
        'b_expert_router': 0.01 * jax.random.normal(ks[25], (DEPTH, N_EXPERTS), jnp.float32),
        'w_expert_gate': w(ks[26], (DEPTH, N_EXPERTS, D_MODEL, EXPERT_FF), D_MODEL),
        'w_expert_up': w(ks[27], (DEPTH, N_EXPERTS, D_MODEL, EXPERT_FF), D_MODEL),
        'w_expert_down': w(ks[28], (DEPTH, N_EXPERTS, EXPERT_FF, D_MODEL), EXPERT_FF),
        'norm_final_g': gain(ks[29], (D_MODEL,)),
    }


def reference(x, mem, positions, norm_mix_g, w_in, diff_lambda_q1, diff_lambda_k1,
              diff_lambda_q2, diff_lambda_k2, diff_out_g, mla_q_norm_g, w_mla_uq,
              mla_kv_norm_g, w_mla_ukv, mla_out_g, w_out, norm_cross_g, norm_mem_g,
              w_mem_q, w_mem_kv, w_mem_o, norm_ffn_g, w_group_router, b_group_router,
              w_expert_router, b_expert_router, w_expert_gate, w_expert_up, w_expert_down,
              norm_final_g):
    b, s, _ = x.shape
    cos, sin = _rope_angles(positions, MLA_ROPE_DIM)
    for l in range(DEPTH):
        h = _rms_norm(x, norm_mix_g[l])
        proj = h @ w_in[l]
        q_d, k_d, v_d, c_q, c_kv, k_pe = jnp.split(proj, IN_SPLITS, axis=-1)

        lambda_init = 0.8 - 0.6 * math.exp(-0.3 * l)
        lam = (jnp.exp(jnp.sum(diff_lambda_q1[l].astype(jnp.float32) * diff_lambda_k1[l].astype(jnp.float32)))
               - jnp.exp(jnp.sum(diff_lambda_q2[l].astype(jnp.float32) * diff_lambda_k2[l].astype(jnp.float32)))
               + lambda_init)
        diff_out = _differential_attention(
            q_d.reshape(b, s, DIFF_HEADS, 2 * DIFF_HALF_DIM),
            k_d.reshape(b, s, DIFF_HEADS, 2 * DIFF_HALF_DIM),
            v_d.reshape(b, s, DIFF_HEADS, DIFF_V_DIM),
            positions, lam, lambda_init, diff_out_g[l])

        q_m = (_rms_norm(c_q, mla_q_norm_g[l]) @ w_mla_uq[l]).reshape(b, s, MLA_HEADS, MLA_QK_DIM)
        q_nope, q_pe = q_m[..., :MLA_NOPE_DIM], q_m[..., MLA_NOPE_DIM:]
        q_pe = _apply_rope(q_pe, cos[:, :, None, :], sin[:, :, None, :])
        q_m = jnp.concatenate([q_nope, q_pe], axis=-1)
        kv_m = (_rms_norm(c_kv, mla_kv_norm_g[l]) @ w_mla_ukv[l]).reshape(
            b, s, MLA_HEADS, MLA_NOPE_DIM + MLA_V_DIM)
        k_nope, v_m = kv_m[..., :MLA_NOPE_DIM], kv_m[..., MLA_NOPE_DIM:]
        k_pe = _apply_rope(k_pe, cos, sin)
        k_m = jnp.concatenate(
            [k_nope, jnp.broadcast_to(k_pe[:, :, None, :], (b, s, MLA_HEADS, MLA_ROPE_DIM))], axis=-1)
        mla_out = _rms_norm(_latent_attention(q_m, k_m, v_m), mla_out_g[l])

        x = x + jnp.concatenate([diff_out, mla_out], axis=-1) @ w_out[l]

        x = x + _memory_cross_attention(_rms_norm(x, norm_cross_g[l]), _rms_norm(mem, norm_mem_g[l]),
                                        w_mem_q[l], w_mem_kv[l], w_mem_o[l])

        x = x + _hierarchical_moe(_rms_norm(x, norm_ffn_g[l]), w_group_router[l], b_group_router[l],
                                  w_expert_router[l], b_expert_router[l],
                                  w_expert_gate[l], w_expert_up[l], w_expert_down[l])
    return _rms_norm(x, norm_final_g)
```

```cpp
#include <hip/hip_runtime.h>
#include <cstdio>
#include <cstdint>

#define LAS __attribute__((address_space(3)))
#define GAS __attribute__((address_space(1)))
typedef unsigned short bf16;
typedef short bf16x8 __attribute__((ext_vector_type(8)));
typedef short s16x4 __attribute__((ext_vector_type(4)));
typedef float f32x4 __attribute__((ext_vector_type(4)));
typedef float f32x2 __attribute__((ext_vector_type(2)));
typedef float f32x16 __attribute__((ext_vector_type(16)));
typedef unsigned u32x4 __attribute__((ext_vector_type(4)));
typedef unsigned u32x2 __attribute__((ext_vector_type(2)));
typedef __bf16 bf16x2_t __attribute__((ext_vector_type(2)));

constexpr int NB = 4, SEQ = 8192, DM = 1024, T = NB * SEQ;
constexpr int NMEM = 256;
constexpr int INW = 1952, INWP = 2048;
constexpr int NEXP = 32, EFF = 256;
constexpr float EPS = 1e-6f;
constexpr float LOG2E = 1.4426950408889634f;
constexpr float QS_D = 0.17677669529663687f * LOG2E;
constexpr float QS_M = 0.10206207261596577f * LOG2E;
constexpr float QS_C = 0.08838834764831845f * LOG2E;
constexpr float LAMBDA_INIT = 0.2f;

constexpr size_t MiB = 1u << 20;
constexpr size_t WS_CTL = 0, CTL_ZERO_BYTES = 1 * MiB;
constexpr size_t WS_WIN = 1 * MiB;
constexpr size_t WS_WUQ = 5 * MiB;
constexpr size_t WS_WUKV = 5 * MiB + 512 * 1024;
constexpr size_t WS_WOUT = 6 * MiB;
constexpr size_t WS_WMQ = 8 * MiB;
constexpr size_t WS_WMKV = 9 * MiB;
constexpr size_t WS_WMO = 11 * MiB;
constexpr size_t WS_WR = 12 * MiB;
constexpr size_t WS_WGU = 13 * MiB;
constexpr size_t WS_WDN = 45 * MiB;
constexpr size_t WS_ROPE = 61 * MiB;
constexpr size_t WS_SSQM = 65 * MiB;
constexpr size_t WS_SSQ1 = 66 * MiB;
constexpr size_t WS_SSQ2 = 68 * MiB;
constexpr size_t WS_SSQQ = 70 * MiB;
constexpr size_t WS_SSQKV = 70 * MiB + 512 * 1024;
constexpr size_t WS_KC = 71 * MiB;
constexpr size_t WS_VC = 72 * MiB;
constexpr size_t WS_MEMN = 73 * MiB;
constexpr size_t WS_WT = 75 * MiB;
constexpr size_t WS_RS2 = 75 * MiB + 512 * 1024;
constexpr size_t WS_MISC = 76 * MiB;
constexpr size_t WS_UTAB = 76 * MiB + 4096;
constexpr size_t WS_POS = 76 * MiB + 65536;
constexpr size_t WS_LIST = 77 * MiB;
constexpr size_t WS_A0 = 84 * MiB;
constexpr size_t WS_QD = 148 * MiB, WS_KD = 180 * MiB, WS_VD = 212 * MiB;
constexpr size_t WS_X1B = 148 * MiB;
constexpr size_t WS_QC = 212 * MiB;
constexpr size_t WS_X2Q = 212 * MiB;
constexpr size_t WS_CQ = 244 * MiB;
constexpr size_t WS_CKV = 260 * MiB;
constexpr size_t WS_QM = 268 * MiB;
constexpr size_t WS_KM = 316 * MiB;
constexpr size_t WS_VM = 364 * MiB;
constexpr size_t WS_X2B = 268 * MiB;
constexpr size_t WS_OC = 332 * MiB;
constexpr size_t WS_X1Q = 364 * MiB;
constexpr size_t WS_Y = 120 * MiB;
constexpr size_t WS_MIX = 396 * MiB;
constexpr size_t WS_RS0 = 76 * MiB + 327680;
constexpr size_t WS_END = 460 * MiB;
constexpr int CW_BAR = 4096;
constexpr int CW_KMAX = 8192;
constexpr int CW_QHEAD = 8448;
constexpr int CW_CNT = 16384;

constexpr int RING_BYTES = 131072;
constexpr int ROUTER_LDS = 2 * 36 * 2064;
constexpr int LDSCTL_OFF = 149504, MISC_OFF = LDSCTL_OFF + 64;
constexpr int TP_OFF = LDSCTL_OFF + 256;
constexpr int LDS_BYTES = 150528;
constexpr int NWAVES = 8;

__device__ __forceinline__ unsigned cvtpk(float lo, float hi) { f32x2 v = {lo, hi}; bf16x2_t b = __builtin_convertvector(v, bf16x2_t); return __builtin_bit_cast(unsigned, b); }
__device__ __forceinline__ float bf_lo(unsigned u) { return __uint_as_float(u << 16); }
__device__ __forceinline__ float bf_hi(unsigned u) { return __uint_as_float(u & 0xffff0000u); }
__device__ __forceinline__ unsigned f2bf(float f) { return cvtpk(f, 0.f) & 0xffffu; }
__device__ __forceinline__ float wave_sum(float v) {
#pragma unroll
    for (int o = 1; o < 64; o <<= 1) v += __shfl_xor(v, o);
    return v;
}
#define LDS_WAIT() asm volatile("s_waitcnt lgkmcnt(0)" ::: "memory")
#define VM_WAIT() asm volatile("s_waitcnt vmcnt(0)" ::: "memory")

#define XB_TMO      128
#define XB_XCNT(j)  (256  + 64 * (j))
#define XB_XSUB(j)  (1280 + 64 * (j))
#define XB_XGEN(j)  (2304 + 64 * (j))
#define XB_TOP      3328
#define XB_TOPGEN   3392
#define XCD_BAR_WORDS 3456
#define XB_SPIN_CAP (1u << 18)
__device__ __forceinline__ unsigned xb_ld(unsigned* p)              { return __hip_atomic_load(p, __ATOMIC_RELAXED, __HIP_MEMORY_SCOPE_AGENT); }
__device__ __forceinline__ unsigned xb_add(unsigned* p, unsigned v) { return __hip_atomic_fetch_add(p, v, __ATOMIC_RELAXED, __HIP_MEMORY_SCOPE_AGENT); }
__device__ __forceinline__ unsigned xb_xcc_id() { return (unsigned)__builtin_amdgcn_s_getreg((3 << 11) | 20) & 0xFu; }
#define XB_SPIN(cond, bar) do { unsigned _sp = 0; while (cond) { __builtin_amdgcn_s_sleep(1); \
    if ((++_sp & 255u) == 0u) { if (xb_ld(&(bar)[XB_TMO])) break; if (_sp > XB_SPIN_CAP) { atomicAdd(&(bar)[XB_TMO], 1u); break; } } } } while (0)
struct XcdBarrier { unsigned* bar; unsigned x; volatile LAS unsigned* st; };
__device__ __forceinline__ XcdBarrier xcd_barrier_post(unsigned* bar, volatile LAS unsigned* st) {
    XcdBarrier b; b.bar = bar; b.x = xb_xcc_id(); b.st = st;
    if (threadIdx.x == 0) (void)xb_add(&bar[XB_XCNT(b.x)], 1u);
    return b;
}
__device__ __forceinline__ void xcd_barrier_complete(unsigned* bar, unsigned x, unsigned& nloc, unsigned& nx) {
    const unsigned G = gridDim.x * gridDim.y * gridDim.z;
    unsigned sum, cnt, mine, sp = 0u;
    for (;;) {
        sum = 0u; cnt = 0u; mine = 0u;
#pragma unroll
        for (unsigned j = 0; j < 16; ++j) { const unsigned c = xb_ld(&bar[XB_XCNT(j)]); sum += c; cnt += (c > 0u) ? 1u : 0u; mine = (j == x) ? c : mine; }
        if (sum == G) break;
        __builtin_amdgcn_s_sleep(1);
        if ((++sp & 255u) == 0u) { if (xb_ld(&bar[XB_TMO])) break; if (sp > XB_SPIN_CAP) { atomicAdd(&bar[XB_TMO], 1u); break; } }
    }
    nloc = mine > 0u ? mine : 1u; nx = cnt > 0u ? cnt : 1u;
}
__device__ __forceinline__ void xcd_barrier(const XcdBarrier& b) {
    asm volatile("s_waitcnt vmcnt(0)" ::: "memory");
    __syncthreads();
    if (threadIdx.x == 0) {
        unsigned* bar = b.bar;
        __builtin_amdgcn_s_waitcnt(0);
        unsigned nloc = b.st[0], nx = b.st[1];
        if (nloc == 0u) { xcd_barrier_complete(bar, b.x, nloc, nx); b.st[0] = nloc; b.st[1] = nx; }
        const unsigned old = xb_add(&bar[XB_XSUB(b.x)], 1u);
        const unsigned gen = old / nloc;
        if (old + 1u == (gen + 1u) * nloc) {
            __builtin_amdgcn_fence(__ATOMIC_RELEASE, "agent");
            asm volatile("s_waitcnt vmcnt(0)" ::: "memory");
            const unsigned og = xb_add(&bar[XB_TOP], 1u);
            const unsigned tg = og / nx;
            if (og + 1u == (tg + 1u) * nx) xb_add(&bar[XB_TOPGEN], 1u);
            else XB_SPIN(xb_ld(&bar[XB_TOPGEN]) == tg, bar);
            __builtin_amdgcn_fence(__ATOMIC_ACQUIRE, "agent");
            xb_add(&bar[XB_XGEN(b.x)], 1u);
            asm volatile("s_waitcnt vmcnt(0)" ::: "memory");
        } else {
            XB_SPIN(xb_ld(&bar[XB_XGEN(b.x)]) == gen, bar);
            __builtin_amdgcn_fence(__ATOMIC_ACQUIRE, "agent");
            asm volatile("s_waitcnt vmcnt(0)" ::: "memory");
        }
    }
    __syncthreads();
}

namespace pg8 {
constexpr int BM = 256, BK = 64, HALF = 128, HTB = HALF * BK * 2, STAGE_BYTES = 8 * HTB, NXCD = 8, WGM = 8;
__device__ __forceinline__ int lds_byte(int r, int c) { const int st = (r >> 4) * 2 + (c >> 5), rr = r & 15, cc = c & 31, ob = rr * 64 + cc * 2; return st * 1024 + (ob ^ (((ob >> 9) & 1) << 5)); }
__device__ __forceinline__ int perm32(int rho) { const int n = rho >> 4, i = rho & 15; return 8 * (i >> 2) + 4 * n + (i & 3); }
__device__ __forceinline__ void stage_rc(int b, int& R, int& C) { const int st = b / 1024, sb = b % 1024, swz = sb ^ (((sb >> 9) & 1) << 5); R = (st >> 1) * 16 + swz / 64; C = (st & 1) * 32 + (swz % 64) / 2; }

struct Unit { int pm, pn, e, cnt; };

struct DenseOrder {
    static constexpr bool GATHER = false;
    int nM, nN, nwg, G, c, lda; const char* B; int ldb; int eb;
    __device__ void init(int M, int N, int G_, int c_, int lda_, const void* B_, int ldb_, int eb_ = 2) { nM = M / BM; nN = N / BM; nwg = nM * nN; G = G_; c = c_; lda = lda_; B = (const char*)B_; ldb = ldb_; eb = eb_; }
    __device__ __forceinline__ bool next(int i, Unit& u) const {
        const long L = (long)i * G + c; if (L >= nwg) return false;
        int wgid = (int)L; { const int q = nwg / NXCD, r = nwg % NXCD, xcd = wgid % NXCD, off = wgid / NXCD; wgid = (xcd < r ? xcd * (q + 1) : r * (q + 1) + (xcd - r) * q) + off; }
        const int nig = WGM * nN, gid = wgid / nig, fm = gid * WGM, gsz = (nM - fm) < WGM ? (nM - fm) : WGM;
        u.pm = fm + ((wgid % nig) % gsz); u.pn = (wgid % nig) / gsz; u.e = 0; u.cnt = 0; return true;
    }
    __device__ __forceinline__ void a_offs(const Unit&, const int (&)[2], const int (&)[2], unsigned (&)[2][2]) const {}
    __device__ __forceinline__ size_t a_rowtile(const Unit& u) const { return (size_t)u.pm; }
    __device__ __forceinline__ const char* b_ptr(const Unit& u) const { return B + (size_t)u.pn * BM * ldb * eb; }
};
struct OneUnit {
    static constexpr bool GATHER = false;
    int pm, pn; const char* B; int ldb; int eb;
    __device__ __forceinline__ bool next(int i, Unit& u) const { int i0 = i; asm volatile("" : "+s"(i0)); if (i0 != 0) return false; u.pm = pm; u.pn = pn; u.e = 0; u.cnt = 0; return true; }
    __device__ __forceinline__ void a_offs(const Unit&, const int (&)[2], const int (&)[2], unsigned (&)[2][2]) const {}
    __device__ __forceinline__ size_t a_rowtile(const Unit& u) const { return (size_t)u.pm; }
    __device__ __forceinline__ const char* b_ptr(const Unit& u) const { return B + (size_t)u.pn * BM * ldb * eb; }
};
struct RowUnits {
    static constexpr bool GATHER = false;
    int pm, n; const char* B; int ldb; int eb;
    __device__ __forceinline__ bool next(int i, Unit& u) const { int i0 = i; asm volatile("" : "+s"(i0)); if (i0 >= n) return false; int p0 = pm; asm volatile("" : "+s"(p0)); u.pm = p0; u.pn = i0; u.e = 0; u.cnt = 0; return true; }
    __device__ __forceinline__ void a_offs(const Unit&, const int (&)[2], const int (&)[2], unsigned (&)[2][2]) const {}
    __device__ __forceinline__ size_t a_rowtile(const Unit& u) const { return (size_t)u.pm; }
    __device__ __forceinline__ const char* b_ptr(const Unit& u) const { return B + (size_t)u.pn * BM * ldb * eb; }
};
struct InProjOrder {
    static constexpr bool GATHER = false;
    int c; const char* B; int ldb;
    __device__ __forceinline__ bool next(int i, Unit& u) const { int i0 = i; asm volatile("" : "+s"(i0)); if (i0 >= 4 || c >= 256) return false;
        const int p = c >> 7, off = (c >> 5) & 3; const int k = (i0 == 3) ? 3 : ((off % 3) + i0) % 3; u.pm = c & 127; u.pn = p + 2 * k; u.e = 0; u.cnt = 0; return true; }
    __device__ __forceinline__ void a_offs(const Unit&, const int (&)[2], const int (&)[2], unsigned (&)[2][2]) const {}
    __device__ __forceinline__ size_t a_rowtile(const Unit& u) const { return (size_t)u.pm; }
    __device__ __forceinline__ const char* b_ptr(const Unit& u) const { return B + (size_t)u.pn * BM * ldb * 2; }
};
template <bool GATHER_> struct MoeOrder {
    static constexpr bool GATHER = GATHER_;
    int G, c, NPN, lda; const char* B; int ldb; size_t bstride; const LAS int* TP; const unsigned* cntw; const int* list; int eb;
    __device__ __forceinline__ bool next(int i, Unit& u) const {
        const int ntile = TP[NEXP]; const long L = (long)i * G + c; if (L >= (long)ntile * NPN) return false;
        const int tile = (int)(L / NPN); u.pn = (int)(L % NPN); u.pm = tile;
        int e = 0;
#pragma nounroll
        for (int k = 1; k < NEXP; ++k) e = (TP[k] <= tile) ? k : e;
        u.e = __builtin_amdgcn_readfirstlane(e);
        u.cnt = (int)__builtin_amdgcn_readfirstlane(__hip_atomic_load(cntw + 64 * u.e, __ATOMIC_RELAXED, __HIP_MEMORY_SCOPE_AGENT));
        return true;
    }
    __device__ __forceinline__ void a_offs(const Unit& u, const int (&RA)[2], const int (&CA)[2], unsigned (&off)[2][2]) const {
        if constexpr (!GATHER) return;
        const int j = u.pm - TP[u.e];
#pragma unroll
        for (int h = 0; h < 2; ++h)
#pragma unroll
            for (int i = 0; i < 2; ++i) {
                const int idx = j * BM + h * HALF + RA[i]; const int a = (idx < u.cnt) ? list[(size_t)u.e * T + idx] : 0;
                off[h][i] = (unsigned)((a >> 1) * lda * eb + CA[i] * 2);
            }
    }
    __device__ __forceinline__ size_t a_rowtile(const Unit& u) const { return (size_t)u.pm; }
    __device__ __forceinline__ const char* b_ptr(const Unit& u) const { return B + (size_t)u.e * bstride + (size_t)u.pn * BM * ldb * eb; }
};

template <class Epi, class Sched, bool ALIGN_EPI>
__device__ __forceinline__ void gemm_phase(LAS unsigned char* lds, const char* Abase, int lda, int ldb, int K, const Sched& S, const Epi& E) {
    int tid_ = threadIdx.x; asm volatile("" : "+v"(tid_));
    const int tid = tid_, wid = __builtin_amdgcn_readfirstlane(tid >> 6), lane = tid & 63, wr = wid >> 2, wc = wid & 3, fr = lane & 15, fq = lane >> 4;
    int Kv_ = K; if (K <= 256) asm volatile("" : "+s"(Kv_));
    constexpr int EB = Epi::FP8 ? 1 : 2;
    const int nt = Kv_ / (128 / EB);
    int RA[2], CA[2]; unsigned voffB[2], voffA[2];
#pragma unroll
    for (int i = 0; i < 2; ++i) { int R, C; stage_rc(tid * 16 + i * 8192, R, C); RA[i] = R; CA[i] = C; const int Rb = Epi::PERM ? ((R & ~31) + perm32(R & 31)) : R; voffB[i] = (unsigned)(Rb * ldb * EB + C * 2); voffA[i] = (unsigned)(R * lda * EB + C * 2); }
    const size_t kstep = (size_t)(BK * 2);
    const size_t hstepB = (size_t)HALF * ldb * EB, hstepA = (size_t)HALF * lda * EB, tstepA = 2 * hstepA;
    const unsigned ldsw = (unsigned)wid * 1024u;
    const int aoff = lds_byte(wr * 64 + fr, fq * 8), boff = lds_byte(wc * 32 + fr, fq * 8);
#define PG8_SA(b, h) (((b) * 2 + (h)) * HTB)
#define PG8_SB(b, h) ((4 + (b) * 2 + (h)) * HTB)
#define PG8_STAGE_B(bufoff, gbase) do { _Pragma("unroll") for (int _i = 0; _i < 2; ++_i) \
        __builtin_amdgcn_global_load_lds((const unsigned*)((const char*)(gbase) + voffB[_i]), (LAS unsigned*)(lds + (bufoff) + ldsw + _i * 8192), 16, 0, 0); } while (0)
#define PG8_GL(src, bufoff) __builtin_amdgcn_global_load_lds((const unsigned*)(src), (LAS unsigned*)(lds + (bufoff) + ldsw + _i * 8192), 16, 0, 0)
#define PG8_STAGE_A(bufoff, h, nx, kb) do { \
        if constexpr (Sched::GATHER) { if (nx) { _Pragma("unroll") for (int _i = 0; _i < 2; ++_i) PG8_GL(Abase + (kb) + oAn[h][_i], bufoff); } \
                                       else    { _Pragma("unroll") for (int _i = 0; _i < 2; ++_i) PG8_GL(Abase + (kb) + oAc[h][_i], bufoff); } } \
        else { const char* _b = ((nx) ? nA : cA) + (h) * hstepA + (kb); _Pragma("unroll") for (int _i = 0; _i < 2; ++_i) PG8_GL(_b + voffA[_i], bufoff); } } while (0)
#define PG8_LDA(dst, b, h) do { _Pragma("unroll") for (int m = 0; m < 4; ++m) { if constexpr (Epi::FP8) { dst##8[m].lo = *(const LAS v4i_t*)(lds + PG8_SA(b, h) + aoff + m * 2048); dst##8[m].hi = *(const LAS v4i_t*)(lds + PG8_SA(b, h) + aoff + m * 2048 + 1024); } \
        else { _Pragma("unroll") for (int k = 0; k < 2; ++k) dst[m][k] = *(const LAS bf16x8*)(lds + PG8_SA(b, h) + aoff + m * 2048 + k * 1024); } } } while (0)
#define PG8_LDB(dst, b, h) do { _Pragma("unroll") for (int n = 0; n < 2; ++n) { if constexpr (Epi::FP8) { dst##8[n].lo = *(const LAS v4i_t*)(lds + PG8_SB(b, h) + boff + n * 2048); dst##8[n].hi = *(const LAS v4i_t*)(lds + PG8_SB(b, h) + boff + n * 2048 + 1024); } \
        else { _Pragma("unroll") for (int k = 0; k < 2; ++k) dst[n][k] = *(const LAS bf16x8*)(lds + PG8_SB(b, h) + boff + n * 2048 + k * 1024); } } } while (0)
#define PG8_MMA(ai, bj, At, Bt) do { __builtin_amdgcn_s_setprio(1); _Pragma("unroll") for (int m = 0; m < 4; ++m) _Pragma("unroll") for (int n = 0; n < 2; ++n) { \
        if constexpr (Epi::FP8) asm volatile("v_mfma_f32_16x16x128_f8f6f4 %0, %1, %2, %0" : "+v"(acc[ai][bj][m][n]) : "v"(Bt##8[n]), "v"(At##8[m]));     \
        else { _Pragma("unroll") for (int k = 0; k < 2; ++k) acc[ai][bj][m][n] = __builtin_amdgcn_mfma_f32_16x16x32_bf16(Bt[n][k], At[m][k], acc[ai][bj][m][n], 0, 0, 0); } } \
        __builtin_amdgcn_s_setprio(0); } while (0)
#define PG8_WAIT_V(n) asm volatile("s_waitcnt vmcnt(" #n ")" ::: "memory")
#define PG8_WAIT_L(n) asm volatile("s_waitcnt lgkmcnt(" #n ")" ::: "memory")
#define PG8_BAR __builtin_amdgcn_s_barrier()
#define PG8_SCHED __builtin_amdgcn_sched_barrier(0)
    Unit cur, nxt; int ui = 0;
    if (!S.next(0, cur)) return;
    f32x4 acc[2][2][4][2];
#pragma unroll
    for (int a = 0; a < 2; ++a)
#pragma unroll
        for (int b = 0; b < 2; ++b)
#pragma unroll
            for (int m = 0; m < 4; ++m)
#pragma unroll
                for (int n = 0; n < 2; ++n) acc[a][b][m][n] = (f32x4){0.f, 0.f, 0.f, 0.f};
    typedef int v8i_t __attribute__((ext_vector_type(8))); typedef int v4i_t __attribute__((ext_vector_type(4)));
    bf16x8 At[4][2], B0[2][2], B1[2][2]; v8i_t At8[4], B08[2], B18[2];
    float rsv[8];
    if constexpr (Epi::KROT > 0) E.preload(cur, wr, fr, rsv);
#define PG8_KO(x) ((Epi::KROT > 0) ? (size_t)(((x) + Epi::KROT) & (nt - 1)) * kstep : (size_t)(x) * kstep)
    unsigned oAc[2][2], oAn[2][2];
    S.a_offs(cur, RA, CA, oAc);
    const char* cB = S.b_ptr(cur); const char* cA = Abase + S.a_rowtile(cur) * tstepA; const char* nA = cA;
    PG8_STAGE_B(PG8_SB(0, 0), cB + PG8_KO(0)); PG8_STAGE_B(PG8_SB(0, 1), cB + hstepB + PG8_KO(0)); PG8_STAGE_A(PG8_SA(0, 0), 0, false, PG8_KO(0)); PG8_STAGE_A(PG8_SA(0, 1), 1, false, PG8_KO(0));
    if (wr == 1) PG8_BAR;
    PG8_WAIT_V(2); PG8_BAR;
    PG8_STAGE_B(PG8_SB(1, 0), cB + PG8_KO(1)); PG8_STAGE_A(PG8_SA(1, 0), 0, false, PG8_KO(1)); PG8_STAGE_B(PG8_SB(1, 1), cB + hstepB + PG8_KO(1));
    PG8_WAIT_V(6); PG8_BAR;
    for (;;) {
        const bool has_next = S.next(ui + 1, nxt);
        const char* nB = cB; nA = cA;
        if (has_next) { S.a_offs(nxt, RA, CA, oAn); nB = S.b_ptr(nxt); nA = Abase + S.a_rowtile(nxt) * tstepA; }
        else if constexpr (Sched::GATHER) {
#pragma unroll
            for (int h = 0; h < 2; ++h)
#pragma unroll
                for (int i = 0; i < 2; ++i) oAn[h][i] = oAc[h][i];
        }
#pragma nounroll
        for (int t = 0; t < nt; t += 2) {
            const bool last = (t == nt - 2);
            const size_t ka1 = PG8_KO(t + 1);
            const size_t ka2 = last ? PG8_KO(0) : PG8_KO(t + 2), ka3 = last ? PG8_KO(1) : PG8_KO(t + 3);
            const char* b2 = (last ? nB : cB) + ka2; const char* b3 = (last ? nB : cB) + ka3;
            if constexpr (Epi::KROT > 0) { if (t == nt - Epi::KROT) E.midk(acc, rsv); }
            PG8_LDB(B0, 0, 0); PG8_LDB(B1, 0, 1); PG8_SCHED; PG8_LDA(At, 0, 0); PG8_STAGE_A(PG8_SA(1, 1), 1, false, ka1);
            PG8_WAIT_V(8); PG8_WAIT_L(0); PG8_BAR; PG8_MMA(0, 0, At, B0); PG8_MMA(0, 1, At, B1); PG8_BAR; PG8_SCHED;
            PG8_LDA(At, 0, 1); PG8_STAGE_B(PG8_SB(0, 0), b2); PG8_STAGE_B(PG8_SB(0, 1), b2 + hstepB); PG8_STAGE_A(PG8_SA(0, 0), 0, last, ka2);
            PG8_WAIT_V(8); PG8_WAIT_L(0); PG8_BAR; PG8_MMA(1, 0, At, B0); PG8_MMA(1, 1, At, B1); PG8_BAR; PG8_SCHED;
            PG8_LDB(B0, 1, 0); PG8_LDB(B1, 1, 1); PG8_SCHED; PG8_LDA(At, 1, 0); PG8_STAGE_A(PG8_SA(0, 1), 1, last, ka2);
            PG8_WAIT_V(8); PG8_WAIT_L(0); PG8_BAR; PG8_MMA(0, 0, At, B0); PG8_MMA(0, 1, At, B1); PG8_BAR; PG8_SCHED;
            PG8_LDA(At, 1, 1); PG8_STAGE_B(PG8_SB(1, 0), b3); PG8_STAGE_B(PG8_SB(1, 1), b3 + hstepB); PG8_STAGE_A(PG8_SA(1, 0), 0, last, ka3);
            PG8_WAIT_V(8); PG8_WAIT_L(0); PG8_BAR; PG8_MMA(1, 0, At, B0); PG8_MMA(1, 1, At, B1); PG8_BAR; PG8_SCHED;
        }
        if constexpr (ALIGN_EPI) { if (wr == 0) PG8_BAR; }
        if constexpr (Epi::FP8) asm volatile("s_nop 15\n\ts_nop 15" ::: "memory");
        E(acc, cur, wr, wc, fr, fq);
        if (!has_next) break;
#pragma unroll
        for (int a = 0; a < 2; ++a)
#pragma unroll
            for (int b = 0; b < 2; ++b)
#pragma unroll
                for (int m = 0; m < 4; ++m)
#pragma unroll
                    for (int n = 0; n < 2; ++n) acc[a][b][m][n] = (f32x4){0.f, 0.f, 0.f, 0.f};
        cur = nxt; cB = nB; cA = nA; ++ui;
        if constexpr (Epi::KROT > 0) E.preload(cur, wr, fr, rsv);
        if constexpr (Sched::GATHER) {
#pragma unroll
            for (int h = 0; h < 2; ++h)
#pragma unroll
                for (int i = 0; i < 2; ++i) oAc[h][i] = oAn[h][i];
        }
        if constexpr (ALIGN_EPI) { if (wr == 1) PG8_BAR; }
    }
    PG8_WAIT_V(0);
    if constexpr (!ALIGN_EPI) { if (wr == 0) PG8_BAR; }
    PG8_BAR;
#undef PG8_KO
#undef PG8_SA
#undef PG8_SB
#undef PG8_STAGE_A
#undef PG8_GL
#undef PG8_STAGE_B
#undef PG8_LDA
#undef PG8_LDB
#undef PG8_MMA
#undef PG8_WAIT_V
#undef PG8_WAIT_L
#undef PG8_BAR
#undef PG8_SCHED
}

typedef f32x4 Acc[2][2][4][2];
#define EPI_ROWS(ai, m) ((ai) * HALF + wr * 64 + (m) * 16 + fr)
#define EPI_COL(bj, n) ((bj) * HALF + wc * 32 + (n) * 16 + 4 * fq)
__device__ __forceinline__ void st4(bf16* p, f32x4 v) { u32x2 w; w.x = cvtpk(v[0], v[1]); w.y = cvtpk(v[2], v[3]); *(u32x2*)p = w; }
#define EPI_COLP(bj) ((bj) * HALF + wc * 32 + 8 * fq)
__device__ __forceinline__ void st16_wt(void* p, u32x4 w) { asm volatile("global_store_dwordx4 %0, %1, off sc1\n\ts_nop 1" :: "v"(p), "v"(w)); }
__device__ __forceinline__ void st8(bf16* p, f32x4 a, f32x4 b) { u32x4 w; w.x = cvtpk(a[0], a[1]); w.y = cvtpk(a[2], a[3]); w.z = cvtpk(b[0], b[1]); w.w = cvtpk(b[2], b[3]); *(u32x4*)p = w; }
__device__ __forceinline__ void st8w(bf16* p, f32x4 a, f32x4 b) { u32x4 w; w.x = cvtpk(a[0], a[1]); w.y = cvtpk(a[2], a[3]); w.z = cvtpk(b[0], b[1]); w.w = cvtpk(b[2], b[3]); st16_wt(p, w); }
__device__ __forceinline__ float sq4(f32x4 v) { return (v[0] * v[0] + v[1] * v[1]) + (v[2] * v[2] + v[3] * v[3]); }

struct EpiInProj {
    static constexpr bool PERM = true; static constexpr int KROT = 0; static constexpr bool FP8 = false;
    bf16 *QD, *KD, *VD, *CQ, *CKV, *KM; float *SSQQ, *SSQKV; const float *rcos, *rsin; unsigned* kmaxw;
    __device__ __forceinline__ void operator()(const Acc& acc, const Unit& u, int wr, int wc, int fr, int fq) const {
        const int pn = u.pn;
        if (pn < 6) {
            bf16* base = QD + (size_t)(pn >> 1) * ((WS_KD - WS_QD) / 2); const float sc = pn < 2 ? QS_D : 1.f; const int cb = (pn & 1) * BM;
#pragma unroll
            for (int ai = 0; ai < 2; ++ai)
#pragma unroll
                for (int m = 0; m < 4; ++m) { bf16* rowp = base + (size_t)(u.pm * BM + EPI_ROWS(ai, m)) * 512 + cb;
#pragma unroll
                    for (int bj = 0; bj < 2; ++bj) st8(rowp + EPI_COLP(bj), acc[ai][bj][m][0] * sc, acc[ai][bj][m][1] * sc); }
            if (pn == 2 || pn == 3) {
#pragma unroll
                for (int bj = 0; bj < 2; ++bj) { float mx = 0.f;
#pragma unroll
                    for (int ai = 0; ai < 2; ++ai)
#pragma unroll
                        for (int m = 0; m < 4; ++m) { float q = sq4(acc[ai][bj][m][0]) + sq4(acc[ai][bj][m][1]); q += __shfl_xor(q, 16); q += __shfl_xor(q, 32); mx = fmaxf(mx, q); }
                    mx = fmaxf(mx, __shfl_xor(mx, 1)); mx = fmaxf(mx, __shfl_xor(mx, 2)); mx = fmaxf(mx, __shfl_xor(mx, 4)); mx = fmaxf(mx, __shfl_xor(mx, 8));
                    const int g32 = (cb + bj * HALF + wc * 32) >> 5;
                    if (fr == 0 && fq == 0) atomicMax(kmaxw + (u.pm >> 5) * 16 + g32, __float_as_uint(mx)); }
            }
        } else if (pn == 6) {
#pragma unroll
            for (int ai = 0; ai < 2; ++ai)
#pragma unroll
                for (int m = 0; m < 4; ++m) { const int row = u.pm * BM + EPI_ROWS(ai, m); bf16* rowp = CQ + (size_t)row * 256; float s = 0.f;
#pragma unroll
                    for (int bj = 0; bj < 2; ++bj) { st8(rowp + EPI_COLP(bj), acc[ai][bj][m][0], acc[ai][bj][m][1]); s += sq4(acc[ai][bj][m][0]) + sq4(acc[ai][bj][m][1]); }
                    s += __shfl_xor(s, 16); s += __shfl_xor(s, 32);
                    if (fq == 0) SSQQ[(size_t)row * 4 + wc] = s; }
        } else {
#pragma unroll
            for (int ai = 0; ai < 2; ++ai)
#pragma unroll
                for (int m = 0; m < 4; ++m) { const int row = u.pm * BM + EPI_ROWS(ai, m); bf16* rowp = CKV + (size_t)row * 128;
                    st8(rowp + EPI_COLP(0), acc[ai][0][m][0], acc[ai][0][m][1]);
                    float s = sq4(acc[ai][0][m][0]) + sq4(acc[ai][0][m][1]);
                    s += __shfl_xor(s, 16); s += __shfl_xor(s, 32);
                    if (fq == 0) SSQKV[(size_t)row * 4 + wc] = s;
                    if (wc == 0) {
                        const f32x4 a0 = acc[ai][1][m][0], a1 = acc[ai][1][m][1]; f32x4 o0, o1;
#pragma unroll
                        for (int q = 0; q < 4; ++q) { o0[q] = __shfl_xor(a0[q], 32); o1[q] = __shfl_xor(a1[q], 32); }
                        const int i0 = 8 * (fq & 1);
                        const f32x4 c0 = *(const f32x4*)(rcos + (size_t)row * 16 + i0), c1 = *(const f32x4*)(rcos + (size_t)row * 16 + i0 + 4);
                        const f32x4 s0 = *(const f32x4*)(rsin + (size_t)row * 16 + i0), s1 = *(const f32x4*)(rsin + (size_t)row * 16 + i0 + 4);
                        const float sg = (fq < 2) ? -1.f : 1.f;
                        const f32x4 r0 = a0 * c0 + o0 * s0 * sg, r1 = a1 * c1 + o1 * s1 * sg;
                        bf16* kp = KM + (size_t)row * 768 + 64 + 8 * fq;
#pragma unroll
                        for (int h = 0; h < 8; ++h) st8(kp + h * 96, r0, r1);
                    }
                    if (m & 1) asm volatile("" ::: "memory"); }
        }
    }
};
struct EpiUpQ {
    static constexpr bool PERM = true; static constexpr int KROT = 0; static constexpr bool FP8 = false;
    bf16* QM; const float* SSQQ; const float *rcos, *rsin;
    __device__ __forceinline__ void operator()(const Acc& acc, const Unit& u, int wr, int wc, int fr, int fq) const {
        float rsv[8];
#pragma unroll
        for (int i = 0; i < 8; ++i) { const f32x4 p = *(const f32x4*)(SSQQ + (size_t)(u.pm * BM + EPI_ROWS(i >> 2, i & 3)) * 4); rsv[i] = __builtin_amdgcn_rsqf(((p[0] + p[1]) + (p[2] + p[3])) * (1.f / 256.f) + EPS) * QS_M; }
#pragma unroll
        for (int i = 0; i < 8; ++i) { const int ai = i >> 2, m = i & 3; const int row = u.pm * BM + EPI_ROWS(ai, m); const float rs = rsv[i];
            bf16* rowp = QM + (size_t)row * 768 + u.pn * BM;
#pragma unroll
            for (int bj = 0; bj < 2; ++bj) { const int g32 = (u.pn * BM + bj * HALF + wc * 32) >> 5;
                f32x4 v0 = acc[ai][bj][m][0] * rs, v1 = acc[ai][bj][m][1] * rs;
                if (g32 % 3 == 2) { f32x4 o0, o1;
#pragma unroll
                    for (int q = 0; q < 4; ++q) { o0[q] = __shfl_xor(v0[q], 32); o1[q] = __shfl_xor(v1[q], 32); }
                    const int i0 = 8 * (fq & 1);
                    const f32x4 c0 = *(const f32x4*)(rcos + (size_t)row * 16 + i0), c1 = *(const f32x4*)(rcos + (size_t)row * 16 + i0 + 4);
                    const f32x4 s0 = *(const f32x4*)(rsin + (size_t)row * 16 + i0), s1 = *(const f32x4*)(rsin + (size_t)row * 16 + i0 + 4);
                    const float sg = (fq < 2) ? -1.f : 1.f;
                    v0 = v0 * c0 + o0 * s0 * sg; v1 = v1 * c1 + o1 * s1 * sg; }
                st8(rowp + EPI_COLP(bj), v0, v1); }
            if (i & 1) asm volatile("" ::: "memory"); }
    }
};
struct EpiUpKV {
    static constexpr bool PERM = true; static constexpr int KROT = 0; static constexpr bool FP8 = false;
    bf16 *KM, *VM; const float* SSQKV;
    __device__ __forceinline__ void operator()(const Acc& acc, const Unit& u, int wr, int wc, int fr, int fq) const {
        float rsv[8];
#pragma unroll
        for (int i = 0; i < 8; ++i) { const f32x4 p = *(const f32x4*)(SSQKV + (size_t)(u.pm * BM + EPI_ROWS(i >> 2, i & 3)) * 4); rsv[i] = __builtin_amdgcn_rsqf(((p[0] + p[1]) + (p[2] + p[3])) * (1.f / 128.f) + EPS); }
#pragma unroll
        for (int i = 0; i < 8; ++i) { const int ai = i >> 2, m = i & 3; const int row = u.pm * BM + EPI_ROWS(ai, m); const float rs = rsv[i];
#pragma unroll
            for (int bj = 0; bj < 2; ++bj) { const int head = u.pn * 2 + bj; const int w32 = wc * 32;
                bf16* dst = (w32 < 64) ? KM + (size_t)row * 768 + head * 96 + w32 : VM + (size_t)row * 512 + head * 64 + (w32 - 64);
                st8(dst + 8 * fq, acc[ai][bj][m][0] * rs, acc[ai][bj][m][1] * rs); } }
    }
};
struct EpiMemKV {
    static constexpr bool PERM = true; static constexpr int KROT = 0; static constexpr bool FP8 = false;
    bf16 *KC, *VC;
    __device__ __forceinline__ void operator()(const Acc& acc, const Unit& u, int wr, int wc, int fr, int fq) const {
        bf16* base = KC + (size_t)(u.pn >> 1) * ((WS_VC - WS_KC) / 2); const int cb = (u.pn & 1) * BM;
#pragma unroll
        for (int ai = 0; ai < 2; ++ai)
#pragma unroll
            for (int m = 0; m < 4; ++m) { bf16* rowp = base + (size_t)(u.pm * BM + EPI_ROWS(ai, m)) * 512 + cb;
#pragma unroll
                for (int bj = 0; bj < 2; ++bj) st8(rowp + EPI_COLP(bj), acc[ai][bj][m][0], acc[ai][bj][m][1]); }
    }
};
template <bool RES_F32, int KROT_ = 0, bool FP8_ = false> struct EpiResid {
    static constexpr bool PERM = true; static constexpr int KROT = KROT_; static constexpr bool FP8 = FP8_;
    const float* resf; const bf16* resb; bf16* XO; float* SSQ; const float* ssqm; unsigned char* XQ; float ascale; const float* rscale;
    __device__ __forceinline__ void preload(const Unit& u, int wr, int fr, float (&rsv)[8]) const {
#pragma unroll
        for (int i = 0; i < 8; ++i) { const f32x4* sp = (const f32x4*)(ssqm + (size_t)(u.pm * BM + EPI_ROWS(i >> 2, i & 3)) * 8); const f32x4 a = sp[0] + sp[1]; rsv[i] = __builtin_amdgcn_rsqf(((a[0] + a[1]) + (a[2] + a[3])) * (1.f / 512.f) + EPS); }
    }
    __device__ __forceinline__ void midk(Acc& acc, const float (&rsv)[8]) const {
#pragma unroll
        for (int i = 0; i < 8; ++i)
#pragma unroll
            for (int bj = 0; bj < 2; ++bj)
#pragma unroll
                for (int n = 0; n < 2; ++n) acc[i >> 2][bj][i & 3][n] *= rsv[i];
    }
    __device__ __forceinline__ void operator()(const Acc& acc, const Unit& u, int wr, int wc, int fr, int fq) const {
#pragma unroll
        for (int ai = 0; ai < 2; ++ai)
#pragma unroll
            for (int m = 0; m < 4; ++m) { const int row = u.pm * BM + EPI_ROWS(ai, m); const size_t ro = (size_t)row * DM + u.pn * BM; float s = 0.f;
#pragma unroll
                for (int bj = 0; bj < 2; ++bj) { const int c = EPI_COLP(bj); f32x4 r0, r1;
                    if (RES_F32) { r0 = *(const f32x4*)(resf + ro + c); r1 = *(const f32x4*)(resf + ro + c + 4); }
                    else { const u32x4 w = *(const u32x4*)(resb + ro + c); r0 = (f32x4){bf_lo(w.x), bf_hi(w.x), bf_lo(w.y), bf_hi(w.y)}; r1 = (f32x4){bf_lo(w.z), bf_hi(w.z), bf_lo(w.w), bf_hi(w.w)};
                        if (rscale) { const float q = rscale[row]; r0 = r0 * q; r1 = r1 * q; } }
                    const f32x4 v0 = r0 + acc[ai][bj][m][0] * ascale, v1 = r1 + acc[ai][bj][m][1] * ascale; st8w(XO + ro + c, v0, v1); s += sq4(v0) + sq4(v1);
                    if (!RES_F32 && XQ) { unsigned w0 = 0, w1 = 0; w0 = __builtin_amdgcn_cvt_pk_fp8_f32(v0[0], v0[1], w0, false); w0 = __builtin_amdgcn_cvt_pk_fp8_f32(v0[2], v0[3], w0, true);
                        w1 = __builtin_amdgcn_cvt_pk_fp8_f32(v1[0], v1[1], w1, false); w1 = __builtin_amdgcn_cvt_pk_fp8_f32(v1[2], v1[3], w1, true); *(u32x2*)(XQ + ro + c) = (u32x2){w0, w1}; } }
                s += __shfl_xor(s, 16); s += __shfl_xor(s, 32);
                if (fq == 0) SSQ[(size_t)row * 16 + u.pn * 4 + wc] = s;
                if (m & 1) asm volatile("" ::: "memory"); }
    }
};
struct EpiCrossQ {
    static constexpr bool PERM = true; static constexpr int KROT = 0; static constexpr bool FP8 = false;
    bf16* QC; const float* SSQ1;
    __device__ __forceinline__ void operator()(const Acc& acc, const Unit& u, int wr, int wc, int fr, int fq) const {
        float rsv[8];
#pragma unroll
        for (int hb = 0; hb < 2; ++hb) {
#pragma unroll
            for (int i = 4 * hb; i < 4 * hb + 4; ++i) { const f32x4* pp = (const f32x4*)(SSQ1 + (size_t)(u.pm * BM + EPI_ROWS(i >> 2, i & 3)) * 16); const f32x4 p = (pp[0] + pp[1]) + (pp[2] + pp[3]);
                rsv[i] = __builtin_amdgcn_rsqf(((p[0] + p[1]) + (p[2] + p[3])) * (1.f / 1024.f) + EPS) * QS_C; }
            asm volatile("" ::: "memory"); }
#pragma unroll
        for (int i = 0; i < 8; ++i) { const int ai = i >> 2, m = i & 3; bf16* rowp = QC + (size_t)(u.pm * BM + EPI_ROWS(ai, m)) * 512 + u.pn * BM;
#pragma unroll
            for (int bj = 0; bj < 2; ++bj) st8(rowp + EPI_COLP(bj), acc[ai][bj][m][0] * rsv[i], acc[ai][bj][m][1] * rsv[i]); }
    }
};
struct EpiMoeUp {
    static constexpr bool PERM = false; static constexpr int KROT = 0; static constexpr bool FP8 = true;
    bf16* H; const int* list; const float* RS2; const LAS int* TP;
    __device__ __forceinline__ void operator()(const Acc& acc, const Unit& u, int wr, int wc, int fr, int fq) const {
        const int j = u.pm - TP[u.e];
        int a[8]; float rsv[8];
#pragma unroll
        for (int i = 0; i < 8; ++i) { const int idx = j * BM + EPI_ROWS(i >> 2, i & 3); a[i] = (idx < u.cnt) ? list[(size_t)u.e * T + idx] : 0; }
#pragma unroll
        for (int i = 0; i < 8; ++i) rsv[i] = RS2[a[i] >> 1] * (1.f / 32.f);
#pragma unroll
        for (int i = 0; i < 8; ++i) { const int ai = i >> 2, m = i & 3; const float rs = rsv[i];
            bf16* rowp = H + (size_t)(u.pm * BM + EPI_ROWS(ai, m)) * EFF;
#pragma unroll
            for (int bj = 0; bj < 2; ++bj) { const int g32 = (u.pn * BM + bj * HALF + wc * 32) >> 5;
                const f32x4 g = acc[ai][bj][m][0] * rs, up = acc[ai][bj][m][1] * rs; f32x4 h;
#pragma unroll
                for (int q = 0; q < 4; ++q) h[q] = g[q] * up[q] * __builtin_amdgcn_rcpf(1.f + __builtin_amdgcn_exp2f(-g[q] * LOG2E));
                { unsigned w_ = 0; w_ = __builtin_amdgcn_cvt_pk_fp8_f32(h[0], h[1], w_, false); w_ = __builtin_amdgcn_cvt_pk_fp8_f32(h[2], h[3], w_, true); *(unsigned*)((unsigned char*)H + (size_t)(u.pm * BM + EPI_ROWS(ai, m)) * EFF + 16 * g32 + 4 * fq) = w_; } } }
    }
};
struct EpiMoeDown {
    static constexpr bool PERM = true; static constexpr int KROT = 0; static constexpr bool FP8 = true;
    bf16* Y;
    __device__ __forceinline__ void operator()(const Acc& acc, const Unit& u, int wr, int wc, int fr, int fq) const {
#pragma unroll
        for (int ai = 0; ai < 2; ++ai)
#pragma unroll
            for (int m = 0; m < 4; ++m) {
#pragma unroll
                for (int bj = 0; bj < 2; ++bj) { const f32x4 v0 = acc[ai][bj][m][0] * (1.f / 16.f), v1 = acc[ai][bj][m][1] * (1.f / 16.f); unsigned w0 = 0, w1 = 0;
                    w0 = __builtin_amdgcn_cvt_pk_fp8_f32(v0[0], v0[1], w0, false); w0 = __builtin_amdgcn_cvt_pk_fp8_f32(v0[2], v0[3], w0, true);
                    w1 = __builtin_amdgcn_cvt_pk_fp8_f32(v1[0], v1[1], w1, false); w1 = __builtin_amdgcn_cvt_pk_fp8_f32(v1[2], v1[3], w1, true);
                    *(u32x2*)((unsigned char*)Y + (size_t)(u.pm * BM + EPI_ROWS(ai, m)) * DM + u.pn * BM + EPI_COLP(bj)) = (u32x2){w0, w1}; } }
    }
};
}

namespace att {
typedef short v4i16_t __attribute__((ext_vector_type(4)));
__device__ __forceinline__ int crow(int r, int hi) { return (r & 3) + 8 * (r >> 2) + 4 * hi; }
__device__ __forceinline__ s16x4 vtr(const LAS unsigned char* p) { return __builtin_bit_cast(s16x4, __builtin_amdgcn_ds_read_tr16_b64_v4i16((LAS v4i16_t*)p)); }

template <int DQK, int NMAP, int DV, bool CAUSAL, bool ALIBI, int qpitch, int kpitch, int vpitch, class Epi>
__device__ __forceinline__ void attn_unit(LAS unsigned char* lds, const bf16* Qp, const bf16* Kp, const bf16* Vp, int NT, int qrow0, float cb, const Epi& epi) {
    constexpr int KW = NMAP * DQK, KCH = KW / 8, KROWB = KW * 2 + 16, KTB = 64 * KROWB, VCH = DV / 8, VTB = 64 * DV * 2, NDB = DV / 32, NDK = DQK / 16;
    constexpr int NKC = (64 * KCH + 511) / 512, NVC = (64 * VCH + 511) / 512;
    static_assert(2 * KTB + 2 * VTB <= RING_BYTES, "attention LDS");
    int tid_ = threadIdx.x; asm volatile("" : "+v"(tid_));
    const int tid = tid_, lane = tid & 63, r32 = lane & 31, hi = lane >> 5; const int wid = __builtin_amdgcn_readfirstlane(tid >> 6);
    bf16x8 qf[NMAP][NDK];
    { const bf16* qrow = Qp + (size_t)(wid * 32 + r32) * qpitch;
#pragma unroll
      for (int mp = 0; mp < NMAP; ++mp)
#pragma unroll
          for (int d0 = 0; d0 < NDK; ++d0) qf[mp][d0] = *(const bf16x8*)(qrow + mp * DQK + d0 * 16 + hi * 8); }
    f32x16 O[NMAP][NDB]; float mrun[NMAP], lrun[NMAP];
#pragma unroll
    for (int mp = 0; mp < NMAP; ++mp) { mrun[mp] = -INFINITY; lrun[mp] = 0.f;
#pragma unroll
        for (int db = 0; db < NDB; ++db)
#pragma unroll
            for (int r = 0; r < 16; ++r) O[mp][db][r] = 0.f; }
    int kgo[NKC], klo[NKC], vgo[NVC], vlo[NVC]; bool kval[NKC], vval[NVC];
#pragma unroll
    for (int c = 0; c < NKC; ++c) { const int id = tid + 512 * c; kval[c] = id < 64 * KCH; const int row = id / KCH, cc = id % KCH; kgo[c] = row * kpitch + cc * 8; klo[c] = row * KROWB + cc * 16; }
#pragma unroll
    for (int c = 0; c < NVC; ++c) { const int id = tid + 512 * c; vval[c] = id < 64 * VCH; const int row = id / VCH, cc = id % VCH; vgo[c] = row * vpitch + cc * 8; vlo[c] = (cc >> 2) * 4096 + row * 64 + (cc & 3) * 16; }
    u32x4 kreg[NKC], vreg[NVC];
#define ATT_LOADG(t) do { _Pragma("unroll") for (int c = 0; c < NKC; ++c) if (kval[c]) kreg[c] = *(const u32x4*)(Kp + (size_t)(t) * 64 * kpitch + kgo[c]); \
        _Pragma("unroll") for (int c = 0; c < NVC; ++c) if (vval[c]) vreg[c] = *(const u32x4*)(Vp + (size_t)(t) * 64 * vpitch + vgo[c]); } while (0)
#define ATT_STORE(b) do { _Pragma("unroll") for (int c = 0; c < NKC; ++c) if (kval[c]) *(LAS u32x4*)(lds + (b) * KTB + klo[c]) = kreg[c]; \
        _Pragma("unroll") for (int c = 0; c < NVC; ++c) if (vval[c]) *(LAS u32x4*)(lds + 2 * KTB + (b) * VTB + vlo[c]) = vreg[c]; } while (0)
    ATT_LOADG(0); ATT_STORE(0); __syncthreads();
    const int afirst = qrow0 + wid * 32;
    float cbr[16];
#pragma unroll
    for (int r = 0; r < 16; ++r) cbr[r] = ALIBI ? cb * (float)crow(r, hi) : 0.f;
    const int vlane = (4 * hi + ((lane & 15) >> 2)) * 64 + (((lane >> 4) & 1) * 16 + (lane & 3) * 4) * 2;
    for (int t = 0; t < NT; ++t) {
        const int cur = t & 1;
        if (t + 1 < NT) ATT_LOADG(t + 1);
        const bool active = !CAUSAL || (64 * t <= afirst);
        if (active) {
            const LAS unsigned char* kb_ = lds + cur * KTB + r32 * KROWB + hi * 16;
            const LAS unsigned char* vb_ = lds + 2 * KTB + cur * VTB + vlane;
            const bool diag = CAUSAL && (64 * t + 63 > afirst);
#pragma unroll
            for (int mp = 0; mp < NMAP; ++mp) {
                f32x16 s[2];
#pragma unroll
                for (int kb = 0; kb < 2; ++kb) {
                    f32x16 a;
                    if (ALIBI) { const float tb = cb * (float)(64 * t + 32 * kb - qrow0 - 255);
#pragma unroll
                        for (int r = 0; r < 16; ++r) a[r] = cbr[r] + tb; }
                    else {
#pragma unroll
                        for (int r = 0; r < 16; ++r) a[r] = 0.f; }
#pragma unroll
                    for (int d0 = 0; d0 < NDK; ++d0) { const bf16x8 kf = *(const LAS bf16x8*)(kb_ + kb * 32 * KROWB + (mp * DQK + d0 * 16) * 2); a = __builtin_amdgcn_mfma_f32_32x32x16_bf16(kf, qf[mp][d0], a, 0, 0, 0); }
                    s[kb] = a; __builtin_amdgcn_sched_barrier(0);
                }
                if (diag) { int qi = afirst + r32; asm volatile("" : "+v"(qi));
#pragma unroll
                    for (int kb = 0; kb < 2; ++kb)
#pragma unroll
                        for (int r = 0; r < 16; ++r) { const int kj = 64 * t + 32 * kb + crow(r, hi); if (kj > qi) s[kb][r] = -INFINITY; } }
                float mx = fmaxf(s[0][0], s[1][0]);
#pragma unroll
                for (int r = 1; r < 16; ++r) mx = fmaxf(mx, fmaxf(s[0][r], s[1][r]));
                mx = fmaxf(mx, __shfl_xor(mx, 32));
                const float mnew = fmaxf(mrun[mp], mx);
                if (__any(mnew > mrun[mp])) {
                    const float alpha = __builtin_amdgcn_exp2f(mrun[mp] - mnew);
                    lrun[mp] *= alpha;
#pragma unroll
                    for (int db = 0; db < NDB; ++db)
#pragma unroll
                        for (int r = 0; r < 16; ++r) O[mp][db][r] *= alpha;
                    mrun[mp] = mnew;
                }
                float ls = 0.f;
#pragma unroll
                for (int kb = 0; kb < 2; ++kb)
#pragma unroll
                    for (int r = 0; r < 16; ++r) { const float p = __builtin_amdgcn_exp2f(s[kb][r] - mnew); s[kb][r] = p; ls += p; }
                lrun[mp] += ls;
#pragma unroll
                for (int s4 = 0; s4 < 4; ++s4) {
                    const int kb = s4 >> 1, hf = (s4 & 1) * 8;
                    u32x4 pw; pw.x = cvtpk(s[kb][hf + 0], s[kb][hf + 1]); pw.y = cvtpk(s[kb][hf + 2], s[kb][hf + 3]); pw.z = cvtpk(s[kb][hf + 4], s[kb][hf + 5]); pw.w = cvtpk(s[kb][hf + 6], s[kb][hf + 7]);
                    const bf16x8 pf = __builtin_bit_cast(bf16x8, pw);
#pragma unroll
                    for (int db = 0; db < NDB; ++db) {
                        const s16x4 lo = vtr(vb_ + db * 4096 + s4 * 1024), hh = vtr(vb_ + db * 4096 + s4 * 1024 + 512);
                        const bf16x8 vf = (bf16x8){lo[0], lo[1], lo[2], lo[3], hh[0], hh[1], hh[2], hh[3]};
                        O[mp][db] = __builtin_amdgcn_mfma_f32_32x32x16_bf16(vf, pf, O[mp][db], 0, 0, 0);
                    }
                }
            }
        }
        if (t + 1 < NT) ATT_STORE(cur ^ 1);
        __syncthreads();
    }
#undef ATT_LOADG
#undef ATT_STORE
    float ltot[NMAP];
#pragma unroll
    for (int mp = 0; mp < NMAP; ++mp) ltot[mp] = lrun[mp] + __shfl_xor(lrun[mp], 32);
    epi(O, ltot, wid * 32 + r32, r32, hi);
}
}


namespace att2 {
#define A2_SBAR() __builtin_amdgcn_sched_barrier(0)
typedef short v4i16_t __attribute__((ext_vector_type(4)));
__device__ __forceinline__ float max3f(float a, float b, float c) { float r; asm("v_max3_f32 %0, %1, %2, %3" : "=v"(r) : "v"(a), "v"(b), "v"(c)); return r; }
__device__ __forceinline__ float max2f(float a, float b) { float r; asm("v_max_f32_e32 %0, %1, %2" : "=v"(r) : "v"(a), "v"(b)); return r; }
__device__ __forceinline__ int crow(int r, int hi) { return (r & 3) + 8 * (r >> 2) + 4 * hi; }
__device__ __forceinline__ s16x4 vtr(const LAS unsigned char* p) { return __builtin_bit_cast(s16x4, __builtin_amdgcn_ds_read_tr16_b64_v4i16((LAS v4i16_t*)p)); }
__device__ __forceinline__ float xhalf_max(float m) { auto rr = __builtin_amdgcn_permlane32_swap(__float_as_uint(m), __float_as_uint(m), false, false); return max2f(__uint_as_float(rr[0]), __uint_as_float(rr[1])); }
__device__ __forceinline__ float xhalf_sum(float m) { auto rr = __builtin_amdgcn_permlane32_swap(__float_as_uint(m), __float_as_uint(m), false, false); return __uint_as_float(rr[0]) + __uint_as_float(rr[1]); }
__device__ __forceinline__ float rowmax32(const f32x16& p0, const f32x16& p1) {
    float a = max3f(p0[0], p0[1], p1[0]), b = max3f(p0[2], p0[3], p1[1]); a = max3f(a, p1[2], p1[3]);
#pragma unroll
    for (int r = 4; r < 16; r += 4) { a = max3f(a, p0[r], p0[r + 1]); b = max3f(b, p0[r + 2], p0[r + 3]); a = max3f(a, p1[r], p1[r + 1]); b = max3f(b, p1[r + 2], p1[r + 3]); }
    return xhalf_max(max2f(a, b));
}
__device__ __forceinline__ void glds16(const void* gsrc, unsigned lds_dst) { unsigned keep;
    asm volatile("s_mov_b32 %0, m0\n\ts_mov_b32 m0, %2\n\ts_nop 0\n\tglobal_load_lds_dwordx4 %1, off\n\ts_mov_b32 m0, %0" : "=&s"(keep) : "v"(gsrc), "s"(lds_dst) : "memory"); }
#define A2_PIN(x) asm volatile("" :: "v"(x))
constexpr float NEGM = -30000.f, THR = 6.f, SKIP_THR = 28.f;
constexpr int VTB = 8192;

template <int DQK, int NMAP, bool ALIBI, int qpitch, int kpitch, int vpitch, class Epi, int VAR = 0>
__device__ __forceinline__ bool unit(LAS unsigned char* lds, const bf16* Qp, const bf16* Kp, const bf16* Vp, int NT, int qrow0, float cb, float kmax0, float kmax1, const Epi& epi, bool chk = true) {
    constexpr int KW = NMAP * DQK, KCH = KW / 8, KROWB = KW * 2 + 16, KTB = 64 * KROWB, NDK = DQK / 16, NQ = 2 * NDK, KA = (NMAP == 1) ? 2 : 1;
    constexpr int NKS = (NMAP == 1) ? 6 : 3, NVS = (NMAP == 1) ? 4 : 2;
    constexpr int OFF_V = NKS * KTB, OFF_FLAG = OFF_V + NVS * VTB;
    static_assert(OFF_FLAG + 64 <= RING_BYTES, "attention LDS");
    int tid_ = threadIdx.x; asm volatile("" : "+v"(tid_));
    const int tid = tid_, lane = tid & 63, r32 = lane & 31, hi = lane >> 5; const int wid = __builtin_amdgcn_readfirstlane(tid >> 6);
    const int chki = __builtin_amdgcn_readfirstlane((int)chk);
    bf16x8 qf[NMAP][NDK];
    { const bf16* qrow = Qp + (size_t)(wid * 32 + r32) * qpitch;
#pragma unroll
      for (int mp = 0; mp < NMAP; ++mp)
#pragma unroll
          for (int d0 = 0; d0 < NDK; ++d0) qf[mp][d0] = *(const bf16x8*)(qrow + mp * DQK + d0 * 16 + hi * 8); }
    f32x16 O[NMAP][2]; float mhat[NMAP], lsum[NMAP], fres[NMAP];
#pragma unroll
    for (int mp = 0; mp < NMAP; ++mp) { mhat[mp] = 0.f; lsum[mp] = 0.f; fres[mp] = 1.f;
#pragma unroll
        for (int db = 0; db < 2; ++db)
#pragma unroll
            for (int r = 0; r < 16; ++r) O[mp][db][r] = 0.f; }
    float qn[NMAP];
    if (ALIBI) {
#pragma unroll
        for (int mp = 0; mp < NMAP; ++mp) { float ss = 0.f;
#pragma unroll
            for (int d0 = 0; d0 < NDK; ++d0)
#pragma unroll
                for (int j = 0; j < 8; ++j) { const float v = __uint_as_float((unsigned)(unsigned short)qf[mp][d0][j] << 16); ss += v * v; }
            qn[mp] = sqrtf(xhalf_sum(ss)) * ((mp == 0) ? kmax0 : kmax1); }
    }
    constexpr int CPR = KCH + 1, KPIECES = (64 * CPR) / 64;
    int kgo[2];
#pragma unroll
    for (int c = 0; c < 2; ++c) { const int sl = 64 * (wid + 8 * c) + lane, row = sl / CPR, cc = sl % CPR; kgo[c] = row * kpitch + (cc == KCH ? 0 : cc) * 8; }
    const int vgo = (16 * (wid & 3) + (lane >> 2)) * vpitch + (wid >> 2) * 32 + (lane & 3) * 8;
    const unsigned lds0 = (unsigned)(uintptr_t)lds;
#define A2_DMAK(u) do { if (VAR == 2) break; const bf16* kt_ = Kp + (size_t)(NT - 1 - (u)) * 64 * kpitch; const unsigned kd_ = (unsigned)__builtin_amdgcn_readfirstlane((int)(lds0 + ((u) % NKS) * KTB + wid * 1024)); \
        glds16(kt_ + kgo[0], kd_); if (wid + 8 < KPIECES) glds16(kt_ + kgo[1], kd_ + 8192u); } while (0)
#define A2_DMAV(u) if (VAR != 2) glds16(Vp + (size_t)(NT - 1 - (u)) * 64 * vpitch + vgo, (unsigned)__builtin_amdgcn_readfirstlane((int)(lds0 + OFF_V + ((u) % NVS) * VTB + wid * 1024)))
    volatile LAS unsigned* flags = (volatile LAS unsigned*)(lds + OFF_FLAG);
    if (lane == 0) { if (ALIBI) flags[wid] = 0u; flags[8 + wid] = 0u; }
    A2_DMAK(0); A2_DMAV(0); A2_DMAK(1); if (KA == 2) { A2_DMAK(2); A2_DMAK(3); A2_DMAV(1); }
    asm volatile("s_waitcnt vmcnt(0)" ::: "memory"); __syncthreads();
    const LAS unsigned char* kfb = lds + r32 * KROWB + hi * 16;
    const LAS unsigned char* vfb = lds + OFF_V + (4 * hi + ((lane & 15) >> 2)) * 64 + (((lane >> 4) & 1) * 16 + (lane & 3) * 4) * 2;
    const int qrel = wid * 32 + r32;
    f32x16 SA0, SA1, SB0, SB1;
    bf16x8 kf[NQ]; s16x4 vl[8], vh[8]; u32x4 pw[4];
#define A2_EL(X0, X1, e) ((e) < 16 ? X0[(e) & 15] : X1[(e) & 15])
#define A2_VRD(f) do { const LAS unsigned char* p_ = vb_ + ((f) & 1) * 4096 + ((f) >> 1) * 1024; vl[f] = vtr(p_); vh[f] = vtr(p_ + 512); } while (0)
#define A2_KRD1(i, slot, mp) kf[i] = *(const LAS bf16x8*)(kfb + (slot) * KTB + ((i) / NDK) * 32 * KROWB + ((mp) * DQK + ((i) % NDK) * 16) * 2)
#define A2_INIT(X, kb, u, mp) do { if (ALIBI) { const float tb_ = cb * (float)(32 * (kb) - 63 - 64 * (u) + 4 * hi) - mhat[mp]; _Pragma("unroll") for (int r = 0; r < 16; ++r) X[r] = __builtin_fmaf(cb, (float)((r & 3) + 8 * (r >> 2)), tb_); } \
        else { const float nm_ = -mhat[mp]; _Pragma("unroll") for (int r = 0; r < 16; ++r) X[r] = nm_; } } while (0)
#define A2_MASK(X0, X1, u) do { if ((u) < 4) { const int kb_ = 192 - 64 * (u) + 4 * hi; \
        _Pragma("unroll") for (int r = 0; r < 16; ++r) { const int kj = kb_ + (r & 3) + 8 * (r >> 2); if (kj > qrel) X0[r] = NEGM; if (kj + 32 > qrel) X1[r] = NEGM; } } } while (0)
    {
#pragma unroll
        for (int i = 0; i < NQ; ++i) A2_KRD1(i, 0, 0);
        A2_INIT(SA0, 0, 0, 0); A2_INIT(SA1, 1, 0, 0);
#pragma unroll
        for (int d0 = 0; d0 < NDK; ++d0) { SA0 = __builtin_amdgcn_mfma_f32_32x32x16_bf16(kf[d0], qf[0][d0], SA0, 0, 0, 0); SA1 = __builtin_amdgcn_mfma_f32_32x32x16_bf16(kf[NDK + d0], qf[0][d0], SA1, 0, 0, 0); }
        A2_MASK(SA0, SA1, 0);
        const float rm = max2f(rowmax32(SA0, SA1), -10000.f); mhat[0] = rm;
#pragma unroll
        for (int r = 0; r < 16; ++r) { SA0[r] = __builtin_amdgcn_exp2f(SA0[r] - rm); SA1[r] = __builtin_amdgcn_exp2f(SA1[r] - rm); }
#pragma unroll
        for (int i = 0; i < NDK; ++i) { if (NMAP == 2) A2_KRD1(i, 0, 1); else A2_KRD1(i, 1, 0); }
    }
#define A2_STEP(CUR0, CUR1, NXT0, NXT1, mpc, u, mpn, un, sl2, mp2, FIRSTN) do { \
        const LAS unsigned char* vb_ = vfb + ((u) % NVS) * VTB; float sacc = 0.f; \
        A2_INIT(NXT0, 0, un, mpn); A2_INIT(NXT1, 1, un, mpn); \
        _Pragma("unroll") for (int g = 0; g < NQ; ++g) { \
            if (g < NDK) A2_KRD1(NDK + g, (un) % NKS, mpn); \
            if (g == NQ - 3) A2_VRD(0); \
            if (g == NQ - 2) A2_VRD(1); \
            A2_SBAR(); \
            if (VAR != 1) { if (g < NDK) NXT0 = __builtin_amdgcn_mfma_f32_32x32x16_bf16(kf[g], qf[mpn][g % NDK], NXT0, 0, 0, 0); else NXT1 = __builtin_amdgcn_mfma_f32_32x32x16_bf16(kf[g], qf[mpn][g % NDK], NXT1, 0, 0, 0); } \
            else { A2_PIN(kf[g]); } \
            if (VAR != 3) { const int e0_ = (g * 32) / NQ, e1_ = ((g + 1) * 32) / NQ; \
                if (NQ == 4) sacc += ((A2_EL(CUR0, CUR1, e0_) + A2_EL(CUR0, CUR1, e0_ + 1)) + (A2_EL(CUR0, CUR1, e0_ + 2) + A2_EL(CUR0, CUR1, e0_ + 3))) + ((A2_EL(CUR0, CUR1, e0_ + 4) + A2_EL(CUR0, CUR1, e0_ + 5)) + (A2_EL(CUR0, CUR1, e0_ + 6) + A2_EL(CUR0, CUR1, e0_ + 7))); \
                else { _Pragma("unroll") for (int e = e0_; e < e1_; ++e) sacc += A2_EL(CUR0, CUR1, e); } } \
            A2_PIN(sacc); \
            if (VAR != 3) { _Pragma("unroll") for (int p = (g * 16) / NQ; p < ((g + 1) * 16) / NQ; ++p) pw[p >> 2][p & 3] = cvtpk(A2_EL(CUR0, CUR1, 2 * p), A2_EL(CUR0, CUR1, 2 * p + 1)); } \
            A2_PIN(pw[((g * 16) / NQ) >> 2]); A2_PIN(pw[(((g + 1) * 16) / NQ - 1) >> 2]); \
            A2_SBAR(); } \
        lsum[mpc] += sacc; \
        A2_MASK(NXT0, NXT1, un); \
        if (FIRSTN || chki != 0 || (un) < 4) { const float rm_ = rowmax32(NXT0, NXT1); \
          if (FIRSTN) { const float rc_ = max2f(rm_, -10000.f); mhat[mpn] = rc_; _Pragma("unroll") for (int r = 0; r < 16; ++r) { NXT0[r] -= rc_; NXT1[r] -= rc_; } } \
          else if ((un) < NT && __builtin_expect(__any(rm_ > THR), 0)) { const float dl = max2f(rm_, 0.f); mhat[mpn] += dl; \
            _Pragma("unroll") for (int r = 0; r < 16; ++r) { NXT0[r] -= dl; NXT1[r] -= dl; } \
            const float f_ = __builtin_amdgcn_exp2f(-dl); lsum[mpn] *= f_; fres[mpn] = f_; } } \
        A2_SBAR(); \
        _Pragma("unroll") for (int f = 0; f < 8; ++f) { \
            _Pragma("unroll") for (int i = (f * NDK) / 8; i < ((f + 1) * NDK) / 8; ++i) A2_KRD1(i, sl2, mp2); \
            if (f + 2 < 8) A2_VRD(f + 2); \
            A2_SBAR(); \
            { const bf16x8 vf_ = (bf16x8){vl[f][0], vl[f][1], vl[f][2], vl[f][3], vh[f][0], vh[f][1], vh[f][2], vh[f][3]}; \
              if (VAR != 1) O[mpc][f & 1] = __builtin_amdgcn_mfma_f32_32x32x16_bf16(vf_, __builtin_bit_cast(bf16x8, pw[f >> 1]), O[mpc][f & 1], 0, 0, 0); else { bf16x8 t_ = vf_; A2_PIN(t_); A2_PIN(pw[f >> 1]); } } \
            if (VAR != 3) { _Pragma("unroll") for (int e = 4 * f; e < 4 * f + 4; ++e) { if (e < 16) NXT0[e & 15] = __builtin_amdgcn_exp2f(NXT0[e & 15]); else NXT1[e & 15] = __builtin_amdgcn_exp2f(NXT1[e & 15]); } } \
            if (f < 4) A2_PIN(NXT0); else A2_PIN(NXT1); \
            A2_SBAR(); } \
        if (FIRSTN || chki != 0 || (un) < 4) _Pragma("unroll") for (int mp_ = 0; mp_ < NMAP; ++mp_) if (__any(fres[mp_] != 1.f)) { \
            _Pragma("unroll") for (int db = 0; db < 2; ++db) _Pragma("unroll") for (int r = 0; r < 16; ++r) O[mp_][db][r] *= fres[mp_]; fres[mp_] = 1.f; } \
    } while (0)
#define A2_ENDTILE(u) do { \
        if (ALIBI && (u) == 3) { float d_ = qn[0] - mhat[0]; if (NMAP == 2) d_ = max2f(d_, qn[NMAP - 1] - mhat[NMAP - 1]); \
            _Pragma("unroll") for (int o_ = 1; o_ < 64; o_ <<= 1) d_ = max2f(d_, __shfl_xor(d_, o_)); \
            if (lane == 0) flags[wid] = __float_as_uint(d_); } \
        if (VAR != 2) { asm volatile("s_waitcnt vmcnt(0)" ::: "memory"); __syncthreads(); } \
        if (ALIBI && (u) == 3) { const u32x4 f0 = *(const LAS u32x4*)(lds + OFF_FLAG), f1 = *(const LAS u32x4*)(lds + OFF_FLAG + 16); \
            const float D_ = max2f(max3f(__uint_as_float(f0.x), __uint_as_float(f0.y), __uint_as_float(f0.z)), max3f(__uint_as_float(f0.w), __uint_as_float(f1.x), __uint_as_float(f1.y))); \
            const float D2_ = max3f(D_, __uint_as_float(f1.z), __uint_as_float(f1.w)); \
            int n_ = (int)floorf((SKIP_THR + D2_) / (64.f * cb)) + 1; n_ = n_ < 4 ? 4 : n_; \
            nt_eff = __builtin_amdgcn_readfirstlane(n_ < NT ? n_ : NT); } \
    } while (0)
    int nt_eff = NT;
    if (NMAP == 2) {
        for (int u = 0; u < nt_eff; ++u) {
            if (u + 2 < NT) A2_DMAK(u + 2);
            if (u + 1 < NT) A2_DMAV(u + 1);
            A2_STEP(SA0, SA1, SB0, SB1, 0, u, NMAP - 1, u, (u + 1) % 3, 0, (u == 0));
            A2_STEP(SB0, SB1, SA0, SA1, NMAP - 1, u, 0, u + 1, (u + 1) % 3, NMAP - 1, false);
            A2_ENDTILE(u);
        }
    } else {
        for (int u = 0; u < NT; u += 2) {
            if (u + 4 < NT) { A2_DMAK(u + 4); A2_DMAK(u + 5); }
            if (u + 2 < NT) { A2_DMAV(u + 2); A2_DMAV(u + 3); }
            A2_STEP(SA0, SA1, SB0, SB1, 0, u, 0, u + 1, (u + 2) % NKS, 0, false);
            A2_STEP(SB0, SB1, SA0, SA1, 0, u + 1, 0, u + 2, (u + 3) % NKS, 0, false);
            A2_ENDTILE(u + 1);
        }
    }
#undef A2_DMAK
#undef A2_DMAV
#undef A2_EL
#undef A2_KRD1
#undef A2_VRD
#undef A2_INIT
#undef A2_MASK
#undef A2_STEP
#undef A2_ENDTILE
    float ltot[NMAP];
#pragma unroll
    for (int mp = 0; mp < NMAP; ++mp) ltot[mp] = xhalf_sum(lsum[mp]);
    epi(O, ltot, wid * 32 + r32, r32, hi);
    if (chk) return false;
    unsigned mxb = 0u;
#pragma unroll
    for (int mp = 0; mp < NMAP; ++mp) { const unsigned lb = __float_as_uint(ltot[mp]) & 0x7fffffffu; mxb = mxb > lb ? mxb : lb;
#pragma unroll
        for (int db = 0; db < 2; ++db)
#pragma unroll
            for (int r = 0; r < 16; ++r) { const unsigned ob = __float_as_uint(O[mp][db][r]) & 0x7fffffffu; mxb = mxb > ob ? mxb : ob; } }
    if (__any(mxb >= 0x7f800000u) && lane == 0) flags[8 + wid] = 1u;
    __syncthreads();
    const u32x4 g0 = *(const LAS u32x4*)(lds + OFF_FLAG + 32), g1 = *(const LAS u32x4*)(lds + OFF_FLAG + 48);
    return (g0.x | g0.y | g0.z | g0.w | g1.x | g1.y | g1.z | g1.w) != 0u;
}
}

struct Args { const void* in[30]; float* out; unsigned char* ws; int ph_lo, ph_hi; int reps, pad_; };
constexpr int N_PHASES = 13;
#ifndef MK_N_LAUNCHES
#define MK_N_LAUNCHES 1
#endif
#ifndef CONV_WG
#define CONV_WG 64
#endif
#ifndef PROBE_VAR
#define PROBE_VAR -1
#endif
#ifndef PROBE_PH
#define PROBE_PH 0
#endif
#ifndef PROBE_REP_MLA
#define PROBE_REP_MLA 1
#endif
#ifndef PROBE_REP_DIFF
#define PROBE_REP_DIFF 1
#endif

struct P0Item { const float* W; const float* gain; unsigned char* WT; int K, N, row_off, goff, mode, f8, k0, n0; float scale; };
__device__ __forceinline__ void p0_item_load(const P0Item& d, int lane, f32x4 (&v)[8], float (&g)[8]) {
    const int lr = lane >> 4, lc = 4 * (lane & 15); const bool cok = (d.n0 + lc) < d.N;
#pragma unroll
    for (int i = 0; i < 8; ++i) { const int k = d.k0 + 4 * i + lr; v[i] = cok ? *(const f32x4*)(d.W + (size_t)k * d.N + d.n0 + lc) : (f32x4){0.f, 0.f, 0.f, 0.f};
        g[i] = (d.gain && k >= d.goff) ? d.gain[k - d.goff] : 1.f; }
}
__device__ __forceinline__ void p0_item_finish(const P0Item& d, int lane, const f32x4 (&v)[8], const float (&g)[8], LAS float* scr) {
    const int lr = lane >> 4, lc = 4 * (lane & 15);
#pragma unroll
    for (int i = 0; i < 8; ++i) { const int kk = 4 * i + lr; const float gs = g[i] * d.scale;
        LAS float* p = scr + kk * 65 + lc; p[0] = v[i][0] * gs; p[1] = v[i][1] * gs; p[2] = v[i][2] * gs; p[3] = v[i][3] * gs; }
    LDS_WAIT(); asm volatile("" ::: "memory");
    const int c = lane & 3;
#pragma unroll
    for (int j = 0; j < 4; ++j) { const int n = (lane >> 2) + 16 * j; const LAS float* sp = scr + (8 * c) * 65 + n;
        const int col = d.n0 + n; int row = col;
        if (d.mode == 1) row = 2 * (col & ~15) + (col & 15);
        if (d.mode == 2) row = 2 * (col & ~15) + 16 + (col & 15);
        if (d.f8) { unsigned w0 = 0, w1 = 0;
            w0 = __builtin_amdgcn_cvt_pk_fp8_f32(sp[0 * 65], sp[1 * 65], w0, false); w0 = __builtin_amdgcn_cvt_pk_fp8_f32(sp[2 * 65], sp[3 * 65], w0, true);
            w1 = __builtin_amdgcn_cvt_pk_fp8_f32(sp[4 * 65], sp[5 * 65], w1, false); w1 = __builtin_amdgcn_cvt_pk_fp8_f32(sp[6 * 65], sp[7 * 65], w1, true);
            if (col < d.N) *(u32x2*)(d.WT + (size_t)(d.row_off + row) * d.K + d.k0 + 8 * c) = (u32x2){w0, w1}; }
        else { u32x4 o; o.x = cvtpk(sp[0 * 65], sp[1 * 65]); o.y = cvtpk(sp[2 * 65], sp[3 * 65]); o.z = cvtpk(sp[4 * 65], sp[5 * 65]); o.w = cvtpk(sp[6 * 65], sp[7 * 65]);
            if (col < d.N) *(u32x4*)(d.WT + ((size_t)(d.row_off + row) * d.K + d.k0 + 8 * c) * 2) = o; } }
    LDS_WAIT(); asm volatile("" ::: "memory");
}
template <int NR> __device__ __forceinline__ void rms_rows_load(const float* xrow, int lane, f32x4 (&v)[NR][4]) {
#pragma unroll
    for (int r = 0; r < NR; ++r)
#pragma unroll
        for (int j = 0; j < 4; ++j) v[r][j] = ((const f32x4*)(xrow + (size_t)r * DM) + lane)[64 * j];
}
template <int NR> __device__ __forceinline__ void rms_rows_finish(const f32x4 (&v)[NR][4], const float* gain, bf16* orow, int lane, float* inv_rs = nullptr) {
    float s[NR];
#pragma unroll
    for (int r = 0; r < NR; ++r) { s[r] = 0.f;
#pragma unroll
        for (int j = 0; j < 4; ++j) s[r] += pg8::sq4(v[r][j]); }
#pragma unroll
    for (int o = 1; o < 64; o <<= 1)
#pragma unroll
        for (int r = 0; r < NR; ++r) s[r] += __shfl_xor(s[r], o);
    const f32x4* gr = (const f32x4*)gain + lane;
    if (inv_rs && lane == 0) {
#pragma unroll
        for (int r = 0; r < NR; ++r) inv_rs[r] = 1.f / __builtin_amdgcn_rsqf(s[r] * (1.f / DM) + EPS); }
#pragma unroll
    for (int j = 0; j < 4; ++j) { const f32x4 g = gain ? gr[64 * j] : (f32x4){1.f, 1.f, 1.f, 1.f};
#pragma unroll
        for (int r = 0; r < NR; ++r) { const float rs = __builtin_amdgcn_rsqf(s[r] * (1.f / DM) + EPS); const f32x4 y = v[r][j] * rs * g; u32x2 w; w.x = cvtpk(y[0], y[1]); w.y = cvtpk(y[2], y[3]); ((u32x2*)(orow + (size_t)r * DM) + lane)[64 * j] = w; } }
}
__device__ __forceinline__ float pk_sq4(float a, float b, float c, float d) { return (a * a + b * b) + (c * c + d * d); }

struct EpiDiff {
    bf16* out; float lam; const float* gain;
    __device__ __forceinline__ void operator()(const f32x16 (&O)[2][2], const float (&l)[2], int qrow, int r32, int hi) const {
        const float i1 = 1.f / l[0], i2 = lam / l[1]; float o[2][16]; float ss = 0.f;
#pragma unroll
        for (int db = 0; db < 2; ++db)
#pragma unroll
            for (int r = 0; r < 16; ++r) { const float v = O[0][db][r] * i1 - O[1][db][r] * i2; o[db][r] = v; ss += v * v; }
        ss += __shfl_xor(ss, 32);
        const float rs = __builtin_amdgcn_rsqf(ss * (1.f / 64.f) + EPS) * (1.f - LAMBDA_INIT);
        bf16* rowp = out + (size_t)qrow * DM;
#pragma unroll
        for (int db = 0; db < 2; ++db)
#pragma unroll
            for (int rq = 0; rq < 4; ++rq) { const int d = 32 * db + 8 * rq + 4 * hi; const f32x4 g = *(const f32x4*)(gain + d);
                const f32x4 v = (f32x4){o[db][4 * rq] * g[0], o[db][4 * rq + 1] * g[1], o[db][4 * rq + 2] * g[2], o[db][4 * rq + 3] * g[3]} * rs; pg8::st4(rowp + d, v); }
    }
};
struct EpiMla {
    bf16* out; float* ssq;
    __device__ __forceinline__ void operator()(const f32x16 (&O)[1][2], const float (&l)[1], int qrow, int r32, int hi) const {
        const float il = 1.f / l[0]; float ss = 0.f; bf16* rowp = out + (size_t)qrow * DM;
#pragma unroll
        for (int db = 0; db < 2; ++db)
#pragma unroll
            for (int rq = 0; rq < 4; ++rq) { const int d = 32 * db + 8 * rq + 4 * hi;
                const f32x4 v = (f32x4){O[0][db][4 * rq], O[0][db][4 * rq + 1], O[0][db][4 * rq + 2], O[0][db][4 * rq + 3]} * il; ss += pg8::sq4(v); pg8::st4(rowp + d, v); }
        ss += __shfl_xor(ss, 32);
        if (hi == 0) ssq[(size_t)qrow * 8] = ss;
    }
};
struct EpiCross {
    unsigned char* out;
    __device__ __forceinline__ void operator()(const f32x16 (&O)[1][4], const float (&l)[1], int qrow, int r32, int hi) const {
        const float il = 8.f / l[0]; unsigned char* rowp = out + (size_t)qrow * 512;
#pragma unroll
        for (int db = 0; db < 4; ++db)
#pragma unroll
            for (int rq = 0; rq < 4; ++rq) { const int d = 32 * db + 8 * rq + 4 * hi; unsigned w = 0;
                w = __builtin_amdgcn_cvt_pk_fp8_f32(O[0][db][4 * rq] * il, O[0][db][4 * rq + 1] * il, w, false); w = __builtin_amdgcn_cvt_pk_fp8_f32(O[0][db][4 * rq + 2] * il, O[0][db][4 * rq + 3] * il, w, true);
                *(unsigned*)(rowp + d) = w; }
    }
};

__global__ void __launch_bounds__(NWAVES * 64, 2) mega_fwd(Args args) {
    extern __shared__ __attribute__((aligned(16))) unsigned char lds_raw[];
    LAS unsigned char* lds = (LAS unsigned char*)lds_raw;
    volatile LAS unsigned* MISC = (volatile LAS unsigned*)(lds + MISC_OFF);
    LAS int* TP = (LAS int*)(lds + TP_OFF);
    const int tid = threadIdx.x, lane = tid & 63, wave = __builtin_amdgcn_readfirstlane(tid >> 6);
    const int G = gridDim.x; const int bx = blockIdx.x; const int vcu = (G % 8 == 0) ? (bx % 8) * (G / 8) + bx / 8 : bx;
    typedef const void* cvp_t;
    __attribute__((address_space(4))) const unsigned char* kp = (__attribute__((address_space(4))) const unsigned char*)__builtin_amdgcn_kernarg_segment_ptr();
    asm volatile("" : "+s"(kp));
#define KARG(i) (*(const __attribute__((address_space(4))) cvp_t*)(kp + 8 * (i)))
#define ws ((unsigned char*)KARG(31))
#define ctl ((unsigned*)(ws + WS_CTL))
#define xin ((const float*)KARG(0))
#define mem ((const float*)KARG(1))
#define positions ((const int*)KARG(2))
#define norm_mix_g ((const float*)KARG(3))
#define w_in ((const float*)KARG(4))
#define lq1 ((const float*)KARG(5))
#define lk1 ((const float*)KARG(6))
#define lq2 ((const float*)KARG(7))
#define lk2 ((const float*)KARG(8))
#define diff_out_g ((const float*)KARG(9))
#define mla_q_norm_g ((const float*)KARG(10))
#define w_mla_uq ((const float*)KARG(11))
#define mla_kv_norm_g ((const float*)KARG(12))
#define w_mla_ukv ((const float*)KARG(13))
#define mla_out_g ((const float*)KARG(14))
#define w_out ((const float*)KARG(15))
#define norm_cross_g ((const float*)KARG(16))
#define norm_mem_g ((const float*)KARG(17))
#define w_mem_q ((const float*)KARG(18))
#define w_mem_kv ((const float*)KARG(19))
#define w_mem_o ((const float*)KARG(20))
#define norm_ffn_g ((const float*)KARG(21))
#define w_group_router ((const float*)KARG(22))
#define b_group_router ((const float*)KARG(23))
#define w_expert_router ((const float*)KARG(24))
#define b_expert_router ((const float*)KARG(25))
#define w_expert_gate ((const float*)KARG(26))
#define w_expert_up ((const float*)KARG(27))
#define w_expert_down ((const float*)KARG(28))
#define norm_final_g ((const float*)KARG(29))
#define W_IN ((bf16*)(ws + WS_WIN))
#define W_UQ ((bf16*)(ws + WS_WUQ))
#define W_UKV ((bf16*)(ws + WS_WUKV))
#define W_OUT ((bf16*)(ws + WS_WOUT))
#define W_MQ ((bf16*)(ws + WS_WMQ))
#define W_MKV ((bf16*)(ws + WS_WMKV))
#define W_MO ((bf16*)(ws + WS_WMO))
#define W_R ((bf16*)(ws + WS_WR))
#define W_GU ((bf16*)(ws + WS_WGU))
#define W_DN ((bf16*)(ws + WS_WDN))
#define RCOS ((float*)(ws + WS_ROPE))
#define SSQM ((float*)(ws + WS_SSQM))
#define SSQ1 ((float*)(ws + WS_SSQ1))
#define SSQ2 ((float*)(ws + WS_SSQ2))
#define SSQQ ((float*)(ws + WS_SSQQ))
#define SSQKV ((float*)(ws + WS_SSQKV))
#define KC ((bf16*)(ws + WS_KC))
#define VC ((bf16*)(ws + WS_VC))
#define MEMN ((bf16*)(ws + WS_MEMN))
#define WTS ((float*)(ws + WS_WT))
#define RS2 ((float*)(ws + WS_RS2))
#define MISCF ((float*)(ws + WS_MISC))
#define LIST ((int*)(ws + WS_LIST))
#define XN ((bf16*)(ws + WS_A0))
#define MIX ((bf16*)(ws + WS_MIX))
#define HB ((bf16*)(ws + WS_A0))
#define QD ((bf16*)(ws + WS_QD))
#define KD ((bf16*)(ws + WS_KD))
#define VD ((bf16*)(ws + WS_VD))
#define X1B ((bf16*)(ws + WS_X1B))
#define QC ((bf16*)(ws + WS_QC))
#define CQ ((bf16*)(ws + WS_CQ))
#define CKV ((bf16*)(ws + WS_CKV))
#define QM ((bf16*)(ws + WS_QM))
#define KM ((bf16*)(ws + WS_KM))
#define VM ((bf16*)(ws + WS_VM))
#define X2B ((bf16*)(ws + WS_X2B))
#define OC ((bf16*)(ws + WS_OC))
#define YB ((bf16*)(ws + WS_Y))
#define RSIN (RCOS + (size_t)T * 16)
#define CNT (ctl + CW_CNT)

    for (int u = tid; u < (LDS_BYTES - LDSCTL_OFF) / 4; u += NWAVES * 64) ((LAS unsigned*)(lds + LDSCTL_OFF))[u] = 0u;
    __syncthreads();
    XcdBarrier bar; bar.bar = ctl + CW_BAR; bar.x = 0; bar.st = nullptr;
    if (MK_N_LAUNCHES == 1) bar = xcd_barrier_post(ctl + CW_BAR, MISC);
    const int lo = *(const __attribute__((address_space(4))) int*)(kp + 256), hi_ph = *(const __attribute__((address_space(4))) int*)(kp + 260);
#ifndef PH_MASK
#define PH_MASK 0xFFFF
#endif
#define IN(k) (((PH_MASK >> (k)) & 1) && lo <= (k) && (k) < hi_ph)
#define SEAM(k) do { if (IN(k) && IN((k) + 1)) xcd_barrier(bar); } while (0)
    const int gw = vcu * NWAVES + wave, NGW = G * NWAVES;

    constexpr int I_IN = 32 * 31, I_UQ = 8 * 12, I_UKV = 4 * 16, I_OUT = 32 * 16, I_MQ = 32 * 8, I_MKV = 32 * 16, I_MO = 16 * 16, I_G = 32 * 4, I_D = 8 * 16;
    constexpr int C0 = NEXP * I_G, C1 = C0 + NEXP * I_G, C2 = C1 + NEXP * I_D, C3 = C2 + I_OUT, C4 = C3 + I_MQ, C5 = C4 + I_MKV, C6 = C5 + I_MO, C7 = C6 + I_UQ, C8 = C7 + I_UKV, C9 = C8 + I_IN;
    _Pragma("unroll") for (int rep_ = 0; rep_ < (((PROBE_PH >> 0) & 1) ? 2 : 1); ++rep_) if (IN(0)) {
        LAS float* scr = (LAS float*)(lds + wave * 16384);
#define P0_DECODE(idx, d) do { int r_ = (idx); int it_; \
            if (r_ < C0) { const int e = r_ / I_G; it_ = r_ % I_G; d = P0Item{w_expert_gate + (size_t)e * DM * EFF, norm_ffn_g, (unsigned char*)W_GU, DM, EFF, e * 512, 0, 1, 1, 0, 0, 32.f}; } \
            else if (r_ < C1) { r_ -= C0; const int e = r_ / I_G; it_ = r_ % I_G; d = P0Item{w_expert_up + (size_t)e * DM * EFF, norm_ffn_g, (unsigned char*)W_GU, DM, EFF, e * 512, 0, 2, 1, 0, 0, 32.f}; } \
            else if (r_ < C2) { r_ -= C1; const int e = r_ / I_D; it_ = r_ % I_D; d = P0Item{w_expert_down + (size_t)e * EFF * DM, nullptr, (unsigned char*)W_DN, EFF, DM, e * 1024, 0, 0, 1, 0, 0, 16.f}; } \
            else if (r_ < C3) { it_ = r_ - C2; d = P0Item{w_out, mla_out_g, (unsigned char*)W_OUT, DM, DM, 0, 512, 0, 0, 0, 0, 1.f}; } \
            else if (r_ < C4) { it_ = r_ - C3; d = P0Item{w_mem_q, norm_cross_g, (unsigned char*)W_MQ, DM, 512, 0, 0, 0, 0, 0, 0, 1.f}; } \
            else if (r_ < C5) { it_ = r_ - C4; d = P0Item{w_mem_kv, nullptr, (unsigned char*)W_MKV, DM, 1024, 0, 0, 0, 0, 0, 0, 1.f}; } \
            else if (r_ < C6) { it_ = r_ - C5; d = P0Item{w_mem_o, nullptr, (unsigned char*)W_MO, 512, 1024, 0, 0, 0, 1, 0, 0, 16.f}; } \
            else if (r_ < C7) { it_ = r_ - C6; d = P0Item{w_mla_uq, mla_q_norm_g, (unsigned char*)W_UQ, 256, 768, 0, 0, 0, 0, 0, 0, 1.f}; } \
            else if (r_ < C8) { it_ = r_ - C7; d = P0Item{w_mla_ukv, mla_kv_norm_g, (unsigned char*)W_UKV, 128, 1024, 0, 0, 0, 0, 0, 0, 1.f}; } \
            else { it_ = r_ - C8; d = P0Item{w_in, norm_mix_g, (unsigned char*)W_IN, DM, INW, 0, 0, 0, 0, 0, 0, 1.f}; } \
            { const int nblk_ = (d.N + 63) / 64; d.k0 = 32 * (it_ / nblk_); d.n0 = 64 * (it_ % nblk_); } } while (0)
        {
            P0Item dc, dn; f32x4 va[8], vb[8]; float ga[8], gb[8];
            int idx = C2 + gw;
            if (idx < C9) { P0_DECODE(idx, dc); p0_item_load(dc, lane, va, ga); }
            while (idx < C9) {
                const int nx = idx + NGW; const bool hn = nx < C9;
                if (hn) { P0_DECODE(nx, dn); p0_item_load(dn, lane, vb, gb); }
                p0_item_finish(dc, lane, va, ga, scr);
                if (hn) { dc = dn;
#pragma unroll
                    for (int i = 0; i < 8; ++i) { va[i] = vb[i]; ga[i] = gb[i]; } }
                idx = nx;
            }
        }
        {
            f32x4 xa[4][4], xb[4][4]; int m = gw * 4;
            if (m < T) rms_rows_load<4>(xin + (size_t)m * DM, lane, xa);
            while (m < T) {
                const int mn = m + NGW * 4; const bool hn = mn < T;
                if (hn) rms_rows_load<4>(xin + (size_t)mn * DM, lane, xb);
                rms_rows_finish<4>(xa, nullptr, XN + (size_t)m * DM, lane, (float*)(ws + WS_RS0) + m);
                if (hn) {
#pragma unroll
                    for (int r = 0; r < 4; ++r)
#pragma unroll
                        for (int j = 0; j < 4; ++j) xa[r][j] = xb[r][j]; }
                m = mn;
            }
        }
        for (int m = gw; m < NB * NMEM; m += NGW) { f32x4 xm[1][4]; rms_rows_load<1>(mem + (size_t)m * DM, lane, xm); rms_rows_finish<1>(xm, norm_mem_g, MEMN + (size_t)m * DM, lane); }
        for (int i = vcu * 512 + tid; i < T * 16; i += G * 512) {
            const int tk = i >> 4, fi = i & 15;
            const float invf = (float)exp2(-(double)fi * (13.287712379549449 / 16.0));
            const float ang = (float)positions[tk] * invf;
            const double xd = (double)ang; const double kq = rint(xd * 0.6366197723675814);
            double rr = fma(-kq, 1.5707963267948966, xd); rr = fma(-kq, 6.123233995736766e-17, rr);
            const double r2 = rr * rr;
            const double sn = rr * (1.0 + r2 * (-1.0 / 6 + r2 * (1.0 / 120 + r2 * (-1.0 / 5040 + r2 * (1.0 / 362880 + r2 * (-1.0 / 39916800))))));
            const double cs = 1.0 + r2 * (-0.5 + r2 * (1.0 / 24 + r2 * (-1.0 / 720 + r2 * (1.0 / 40320 + r2 * (-1.0 / 3628800 + r2 * (1.0 / 479001600))))));
            const int q = ((int)kq) & 3;
            const double c = (q == 0) ? cs : (q == 1) ? -sn : (q == 2) ? -cs : sn;
            const double s = (q == 0) ? sn : (q == 1) ? cs : (q == 2) ? -sn : -cs;
            RCOS[i] = (float)c; RSIN[i] = (float)s;
        }
        for (int i = vcu * 512 + tid; i < 36 * DM; i += G * 512) {
            const int n = i / DM, k = i % DM;
            const float w = (n < 32 ? w_expert_router[(size_t)k * 32 + n] : w_group_router[(size_t)k * 4 + (n - 32)]) * norm_ffn_g[k];
            const unsigned h = f2bf(w); const float res = w - __uint_as_float(h << 16);
            W_R[i] = (bf16)h; W_R[36 * DM + i] = (bf16)f2bf(res);
        }
        if (bx == 0 && wave == 0) {
            float a = (lane < 32) ? lq1[lane] * lk1[lane] : 0.f, b = (lane < 32) ? lq2[lane] * lk2[lane] : 0.f;
            a = wave_sum(a); b = wave_sum(b);
            if (lane == 0) MISCF[0] = expf(a) - expf(b) + LAMBDA_INIT;
        }
    }
    SEAM(0);
    _Pragma("unroll") for (int rep_ = 0; rep_ < (((PROBE_PH >> 1) & 1) ? 2 : 1); ++rep_) if (IN(1)) {
        { pg8::InProjOrder S{bx, (const char*)W_IN, DM};
          pg8::EpiInProj E{QD, KD, VD, CQ, CKV, KM, SSQQ, SSQKV, RCOS, RSIN, ctl + CW_KMAX};
          pg8::gemm_phase<pg8::EpiInProj, pg8::InProjOrder, true>(lds, (const char*)XN, DM, DM, DM, S, E); }
        asm volatile("s_waitcnt vmcnt(0)" ::: "memory"); __syncthreads();
        if (bx < 128) { pg8::RowUnits S{bx & 127, 3, (const char*)W_UQ, 256, 2}; pg8::EpiUpQ E{QM, SSQQ, RCOS, RSIN};
            pg8::gemm_phase<pg8::EpiUpQ, pg8::RowUnits, true>(lds, (const char*)CQ, 256, 256, 256, S, E); }
        else if (bx < 256) { pg8::RowUnits S{bx & 127, 4, (const char*)W_UKV, 128, 2}; pg8::EpiUpKV E{KM, VM, SSQKV};
            pg8::gemm_phase<pg8::EpiUpKV, pg8::RowUnits, true>(lds, (const char*)CKV, 128, 128, 128, S, E); }
    }
    if (IN(2) && bx == G - 1) {
        LAS int* hist = (LAS int*)lds; int* UTAB = (int*)(ws + WS_UTAB);
        for (int ty = 0; ty < 2; ++ty) {
            __syncthreads();
            for (int i = tid; i < 136; i += 512) hist[i] = 0;
            __syncthreads();
            int cost[2];
#pragma unroll
            for (int k = 0; k < 2; ++k) { const int id = tid + 512 * k, qb = id & 31, h = (id >> 5) & 7; int tiles = 4 * (qb + 1);
                if (ty == 0) { const int est = 5 + ((72 << h) + 63) / 64; tiles = tiles < est ? tiles : est; }
                cost[k] = tiles; atomicAdd((int*)&hist[128 - tiles], 1); }
            __syncthreads();
            if (tid == 0) { int acc = 0; for (int i = 0; i < 129; ++i) { const int c = hist[i]; hist[i] = acc; acc += c; } }
            __syncthreads();
#pragma unroll
            for (int k = 0; k < 2; ++k) { const int pos = atomicAdd((int*)&hist[128 - cost[k]], 1); UTAB[ty * 1024 + pos] = tid + 512 * k; }
        }
        __syncthreads();
    }
    SEAM(2);
    if (IN(3)) {
        const float lam = MISCF[0];
        { pg8::DenseOrder S; S.init(NB * NMEM, 1024, 16, bx, DM, W_MKV, DM); pg8::EpiMemKV E{KC, VC};
          if (bx < 16) pg8::gemm_phase<pg8::EpiMemKV, pg8::DenseOrder, true>(lds, (const char*)MEMN, DM, DM, DM, S, E); }
        if (bx >= 16 && bx < 16 + CONV_WG) {
            int tid_c = threadIdx.x; asm volatile("" : "+v"(tid_c));
            const int lane_c = tid_c & 63, wave_c = __builtin_amdgcn_readfirstlane(tid_c >> 6);
            LAS float* scr = (LAS float*)(lds + wave_c * 16384);
            P0Item dc, dn; f32x4 va[8], vb[8]; float ga[8], gb[8];
            int idx = (bx - 16) * NWAVES + wave_c;
            if (idx < C2) { P0_DECODE(idx, dc); p0_item_load(dc, lane_c, va, ga); }
            while (idx < C2) {
                const int nx = idx + CONV_WG * NWAVES; const bool hn = nx < C2;
                if (hn) { P0_DECODE(nx, dn); p0_item_load(dn, lane_c, vb, gb); }
                p0_item_finish(dc, lane_c, va, ga, scr);
                if (hn) { dc = dn;
#pragma unroll
                    for (int i = 0; i < 8; ++i) { va[i] = vb[i]; ga[i] = gb[i]; } }
                idx = nx;
            }
            __syncthreads();
        }
        const int* UTAB = (const int*)(ws + WS_UTAB);
        volatile LAS int* qslot = (volatile LAS int*)(lds + TP_OFF + 160);
#ifndef ATT_NO_DIFF
        {
            if (tid == 0) qslot[0] = (int)atomicAdd(ctl + CW_QHEAD, 1u);
            __syncthreads();
            bool chk = false; int nxt = 0;
            for (;;) {
                const int qi = qslot[0];
                __syncthreads();
                if (qi >= 1024) break;
                if (!chk && tid == 0) nxt = (int)atomicAdd(ctl + CW_QHEAD, 1u);
                const int id = UTAB[qi], qb = id & 31, bh = id >> 5, b = bh >> 3, h = bh & 7;
                const size_t rowb = (size_t)b * SEQ; const int q0 = qb * 256; const int NT = (q0 + 256) / 64;
                const float km0 = sqrtf(__uint_as_float(__hip_atomic_load(ctl + CW_KMAX + b * 16 + h * 2, __ATOMIC_RELAXED, __HIP_MEMORY_SCOPE_AGENT))) * 1.02f;
                const float km1 = sqrtf(__uint_as_float(__hip_atomic_load(ctl + CW_KMAX + b * 16 + h * 2 + 1, __ATOMIC_RELAXED, __HIP_MEMORY_SCOPE_AGENT))) * 1.02f;
                EpiDiff E{MIX + (rowb + q0) * DM + h * 64, lam, diff_out_g};
                const bool bad = __builtin_amdgcn_readfirstlane((int)att2::unit<32, 2, true, 512, 512, 512, EpiDiff>(lds, QD + (rowb + q0) * 512 + h * 64, KD + rowb * 512 + h * 64, VD + rowb * 512 + h * 64, NT, q0, LOG2E * __builtin_amdgcn_exp2f(-(float)(h + 1)), km0, km1, E, chk)) != 0;
                chk = bad;
                if (!bad && tid == 0) qslot[0] = nxt;
                __syncthreads();
            }
        }
#endif
#ifndef ATT_NO_MLA
        {
            if (tid == 0) qslot[0] = (int)atomicAdd(ctl + CW_QHEAD + 64, 1u);
            __syncthreads();
            bool chk = false; int nxt = 0;
            for (;;) {
                const int qi = qslot[0];
                __syncthreads();
                if (qi >= 1024) break;
                if (!chk && tid == 0) nxt = (int)atomicAdd(ctl + CW_QHEAD + 64, 1u);
                const int id = UTAB[1024 + qi], qb = id & 31, bh = id >> 5, b = bh >> 3, h = bh & 7;
                const size_t rowb = (size_t)b * SEQ; const int q0 = qb * 256; const int NT = (q0 + 256) / 64;
                EpiMla E{MIX + (rowb + q0) * DM + 512 + h * 64, SSQM + (rowb + q0) * 8 + h};
                const bool bad = __builtin_amdgcn_readfirstlane((int)att2::unit<96, 1, false, 768, 768, 512, EpiMla>(lds, QM + (rowb + q0) * 768 + h * 96, KM + rowb * 768 + h * 96, VM + rowb * 512 + h * 64, NT, q0, 0.f, 0.f, 0.f, E, chk)) != 0;
                chk = bad;
                if (!bad && tid == 0) qslot[0] = nxt;
                __syncthreads();
            }
        }
#endif
#if PROBE_VAR >= 0
        for (int L = vcu; L < 1024; L += G) {
            const int round = L >> 8, slot = L & 255, bh = slot >> 3, s = slot & 7, b = bh >> 3, h = bh & 7, i = round & 3;
            const int qb = (i == 0) ? s : (i == 1) ? 15 - s : (i == 2) ? 16 + s : 31 - s;
            const size_t rowb = (size_t)b * SEQ; const int q0 = qb * 256; const int NT = (q0 + 256) / 64;
            EpiMla E{(bf16*)(ws + 400 * MiB) + (rowb + q0) * DM + 512 + h * 64, (float*)(ws + 470 * MiB) + (rowb + q0) * 8 + h};
            att2::unit<96, 1, false, 768, 768, 512, EpiMla, PROBE_VAR>(lds, QM + (rowb + q0) * 768 + h * 96, KM + rowb * 768 + h * 96, VM + rowb * 512 + h * 64, NT, q0, 0.f, 0.f, 0.f, E);
        }
#endif
    }
    SEAM(3);
    _Pragma("unroll") for (int rep_ = 0; rep_ < (((PROBE_PH >> 5) & 1) ? 2 : 1); ++rep_) if (IN(5)) {
        pg8::DenseOrder S; S.init(T, DM, G, bx, DM, W_OUT, DM); pg8::EpiResid<false, 8> E{nullptr, XN, X1B, SSQ1, SSQM, nullptr, 1.f, (const float*)(ws + WS_RS0)};
        pg8::gemm_phase<pg8::EpiResid<false, 8>, pg8::DenseOrder, true>(lds, (const char*)MIX, DM, DM, DM, S, E);
    }
    SEAM(5);
    _Pragma("unroll") for (int rep_ = 0; rep_ < (((PROBE_PH >> 6) & 1) ? 2 : 1); ++rep_) if (IN(6)) {
#define P67_BODY(L) do { \
            const int pm = (L) >> 1, pn = (L) & 1; \
            { pg8::OneUnit S{pm, pn, (const char*)W_MQ, DM, 2}; pg8::EpiCrossQ E{QC, SSQ1}; \
              pg8::gemm_phase<pg8::EpiCrossQ, pg8::OneUnit, true>(lds, (const char*)X1B, DM, DM, DM, S, E); } \
            asm volatile("s_waitcnt vmcnt(0)" ::: "memory"); __syncthreads(); \
            const int b = pm >> 5; const size_t row0 = (size_t)pm * 256; \
_Pragma("unroll 1") \
            for (int hh = 0; hh < 2; ++hh) { const int h = pn * 2 + hh; \
                EpiCross E{(unsigned char*)OC + row0 * 512 + h * 128}; \
                att::attn_unit<128, 1, 128, false, false, 512, 512, 512, EpiCross>(lds, QC + row0 * 512 + h * 128, KC + (size_t)b * NMEM * 512 + h * 128, VC + (size_t)b * NMEM * 512 + h * 128, NMEM / 64, 0, 0.f, E); } \
        } while (0)
        if (vcu < 256) P67_BODY(vcu);
#undef P67_BODY
    }
    SEAM(7);
    _Pragma("unroll") for (int rep_ = 0; rep_ < (((PROBE_PH >> 8) & 1) ? 2 : 1); ++rep_) if (IN(8)) {
        pg8::DenseOrder S; S.init(T, DM, G, bx, 512, W_MO, 512, 1); pg8::EpiResid<false, 0, true> E{nullptr, X1B, X2B, SSQ2, nullptr, ws + WS_X2Q, 1.f / 128.f, nullptr};
        pg8::gemm_phase<pg8::EpiResid<false, 0, true>, pg8::DenseOrder, true>(lds, (const char*)OC, 512, 512, 512, S, E);
    }
    SEAM(8);
    if (IN(9)) {
        for (int i = tid; i < 2 * 36 * 128; i += 512) { const int rowi = i >> 7, ch = i & 127; *(LAS u32x4*)(lds + rowi * 2064 + ch * 16) = *(const u32x4*)(W_R + (size_t)rowi * DM + ch * 8); }
        __syncthreads();
        const int r32 = lane & 31, hi = lane >> 5;
        const int m1 = 32 + (r32 < 4 ? r32 : 3);
        LAS unsigned* lcnt = (LAS unsigned*)(lds + TP_OFF + 256); LAS unsigned* lbase = lcnt + 32;
        for (int tt0 = 0; tt0 < T / 32; tt0 += NGW) {
            const int tt = tt0 + wave * G + vcu; const bool act = tt < T / 32;
            if (tid < 32) lcnt[tid] = 0u;
            __syncthreads();
            int e1 = 0, e2 = 0; unsigned p1 = 0, p2 = 0; float w1 = 0.f, w2 = 0.f; const int tok = tt * 32 + r32;
            if (act) {
                const bf16* xrow = X2B + (size_t)tok * DM + hi * 8;
                f32x16 a0, a1;
#pragma unroll
                for (int r = 0; r < 16; ++r) { a0[r] = 0.f; a1[r] = 0.f; }
#pragma unroll 4
                for (int s = 0; s < 64; ++s) {
                    const bf16x8 xf = *(const bf16x8*)(xrow + s * 16);
                    const LAS unsigned char* wp = lds + s * 32 + hi * 16;
                    const bf16x8 w0h = *(const LAS bf16x8*)(wp + r32 * 2064), w0l = *(const LAS bf16x8*)(wp + (36 + r32) * 2064);
                    const bf16x8 w1h = *(const LAS bf16x8*)(wp + m1 * 2064), w1l = *(const LAS bf16x8*)(wp + (36 + m1) * 2064);
                    a0 = __builtin_amdgcn_mfma_f32_32x32x16_bf16(w0h, xf, a0, 0, 0, 0); a0 = __builtin_amdgcn_mfma_f32_32x32x16_bf16(w0l, xf, a0, 0, 0, 0);
                    a1 = __builtin_amdgcn_mfma_f32_32x32x16_bf16(w1h, xf, a1, 0, 0, 0); a1 = __builtin_amdgcn_mfma_f32_32x32x16_bf16(w1l, xf, a1, 0, 0, 0);
                }
                const f32x4* pp = (const f32x4*)(SSQ2 + (size_t)tok * 16); const f32x4 p = (pp[0] + pp[1]) + (pp[2] + pp[3]);
                const float rs = __builtin_amdgcn_rsqf(((p[0] + p[1]) + (p[2] + p[3])) * (1.f / 1024.f) + EPS);
                float gl[4];
#pragma unroll
                for (int g = 0; g < 4; ++g) { const float mine = a1[g]; const float other = __shfl_xor(mine, 32); gl[g] = (hi == 0 ? mine : other) * rs + b_group_router[g]; }
                int gs = 0; float gm = gl[0];
#pragma unroll
                for (int g = 1; g < 4; ++g) if (gl[g] > gm) { gm = gl[g]; gs = g; }
                float gden = 0.f;
#pragma unroll
                for (int g = 0; g < 4; ++g) gden += __expf(gl[g] - gm);
                const float ggate = 1.f / gden;
                float mine4[4];
#pragma unroll
                for (int j = 0; j < 4; ++j) { const float v = (gs == 0) ? a0[j] : (gs == 1) ? a0[4 + j] : (gs == 2) ? a0[8 + j] : a0[12 + j]; mine4[j] = v * rs + b_expert_router[8 * gs + 4 * hi + j]; }
                float v8[8];
#pragma unroll
                for (int j = 0; j < 4; ++j) { const float o = __shfl_xor(mine4[j], 32); v8[j] = hi == 0 ? mine4[j] : o; v8[4 + j] = hi == 0 ? o : mine4[j]; }
                int i1 = 0; float b1 = v8[0];
#pragma unroll
                for (int j = 1; j < 8; ++j) if (v8[j] > b1) { b1 = v8[j]; i1 = j; }
                int i2 = -1; float b2 = -INFINITY;
#pragma unroll
                for (int j = 0; j < 8; ++j) if (j != i1 && v8[j] > b2) { b2 = v8[j]; i2 = j; }
                const float dd = __expf(b2 - b1); w1 = ggate / (1.f + dd); w2 = w1 * dd;
                e1 = 8 * gs + i1; e2 = 8 * gs + i2;
                if (hi == 0) { RS2[tok] = rs; p1 = atomicAdd((unsigned*)(lds_raw + TP_OFF + 256) + e1, 1u); p2 = atomicAdd((unsigned*)(lds_raw + TP_OFF + 256) + e2, 1u); }
            }
            __syncthreads();
            if (tid < 32) { const unsigned c = lcnt[tid]; lbase[tid] = c ? atomicAdd(CNT + 64 * tid, c) : 0u; }
            __syncthreads();
            if (act && hi == 0) {
                LIST[(size_t)e1 * T + lbase[e1] + p1] = 2 * tok; WTS[2 * tok] = w1; ((int*)(ws + WS_POS))[2 * tok] = (e1 << 16) | (int)(lbase[e1] + p1);
                LIST[(size_t)e2 * T + lbase[e2] + p2] = 2 * tok + 1; WTS[2 * tok + 1] = w2; ((int*)(ws + WS_POS))[2 * tok + 1] = (e2 << 16) | (int)(lbase[e2] + p2);
            }
            __syncthreads();
        }
    }
    SEAM(9);
    if (IN(10) || IN(11) || IN(12)) {
        if (tid == 0) { int acc = 0; for (int e = 0; e < NEXP; ++e) { TP[e] = acc; acc += (int)((__hip_atomic_load(CNT + 64 * e, __ATOMIC_RELAXED, __HIP_MEMORY_SCOPE_AGENT) + 255u) >> 8); } TP[NEXP] = acc; }
        __syncthreads();
    }
    _Pragma("unroll") for (int rep_ = 0; rep_ < (((PROBE_PH >> 10) & 1) ? 2 : 1); ++rep_) if (IN(10)) {
        pg8::MoeOrder<true> S{G, vcu, 2, DM, (const char*)W_GU, DM, (size_t)512 * DM, TP, CNT, LIST, 1};
        pg8::EpiMoeUp E{HB, LIST, RS2, TP};
        pg8::gemm_phase<pg8::EpiMoeUp, pg8::MoeOrder<true>, true>(lds, (const char*)(ws + WS_X2Q), DM, DM, DM, S, E);
    }
    SEAM(10);
    _Pragma("unroll") for (int rep_ = 0; rep_ < (((PROBE_PH >> 11) & 1) ? 2 : 1); ++rep_) if (IN(11)) {
        pg8::MoeOrder<false> S{G, vcu, 4, EFF, (const char*)W_DN, EFF, (size_t)1024 * EFF, TP, CNT, LIST, 1};
        pg8::EpiMoeDown E{YB};
        pg8::gemm_phase<pg8::EpiMoeDown, pg8::MoeOrder<false>, true>(lds, (const char*)HB, EFF, EFF, EFF, S, E);
    }
    SEAM(11);
    _Pragma("unroll") for (int rep_ = 0; rep_ < (((PROBE_PH >> 12) & 1) ? 2 : 1); ++rep_) if (IN(12)) {
        const f32x4 g00 = *(const f32x4*)(norm_final_g + lane * 8), g01 = *(const f32x4*)(norm_final_g + lane * 8 + 4), g10 = *(const f32x4*)(norm_final_g + (lane + 64) * 8), g11 = *(const f32x4*)(norm_final_g + (lane + 64) * 8 + 4);
        for (int m0 = gw * 4; m0 < T; m0 += NGW * 4) {
            u32x4 a[4][2]; u32x2 b[4][2], c[4][2]; float wa[4], wb[4];
#pragma unroll
            for (int r = 0; r < 4; ++r) { const int m = m0 + r;
                const int pa = ((const int*)(ws + WS_POS))[2 * m], pb = ((const int*)(ws + WS_POS))[2 * m + 1];
                const size_t sa = (size_t)TP[pa >> 16] * 256 + (pa & 0xffff), sb = (size_t)TP[pb >> 16] * 256 + (pb & 0xffff);
                wa[r] = WTS[2 * m]; wb[r] = WTS[2 * m + 1];
                const u32x4* xp = (const u32x4*)(X2B + (size_t)m * DM); const u32x2* y0 = (const u32x2*)((const unsigned char*)YB + sa * DM); const u32x2* y1 = (const u32x2*)((const unsigned char*)YB + sb * DM);
#pragma unroll
                for (int j = 0; j < 2; ++j) { a[r][j] = xp[lane + 64 * j]; b[r][j] = y0[lane + 64 * j]; c[r][j] = y1[lane + 64 * j]; } }
#pragma unroll
            for (int r = 0; r < 4; ++r) { const int m = m0 + r; float v[2][8]; float s = 0.f;
#pragma unroll
                for (int j = 0; j < 2; ++j)
#pragma unroll
                    for (int q2 = 0; q2 < 2; ++q2) { const f32x2 yb0 = __builtin_amdgcn_cvt_pk_f32_fp8(b[r][j][q2], false), yb1 = __builtin_amdgcn_cvt_pk_f32_fp8(b[r][j][q2], true), yc0 = __builtin_amdgcn_cvt_pk_f32_fp8(c[r][j][q2], false), yc1 = __builtin_amdgcn_cvt_pk_f32_fp8(c[r][j][q2], true);
                        const unsigned xa = a[r][j][2 * q2], xb = a[r][j][2 * q2 + 1];
                        v[j][4 * q2] = bf_lo(xa) + wa[r] * yb0[0] + wb[r] * yc0[0]; v[j][4 * q2 + 1] = bf_hi(xa) + wa[r] * yb0[1] + wb[r] * yc0[1];
                        v[j][4 * q2 + 2] = bf_lo(xb) + wa[r] * yb1[0] + wb[r] * yc1[0]; v[j][4 * q2 + 3] = bf_hi(xb) + wa[r] * yb1[1] + wb[r] * yc1[1];
                        s += (v[j][4 * q2] * v[j][4 * q2] + v[j][4 * q2 + 1] * v[j][4 * q2 + 1]) + (v[j][4 * q2 + 2] * v[j][4 * q2 + 2] + v[j][4 * q2 + 3] * v[j][4 * q2 + 3]); }
                const float rs = __builtin_amdgcn_rsqf(wave_sum(s) * (1.f / DM) + EPS);
                float* orow = (float*)KARG(30) + (size_t)m * DM;
                *(f32x4*)(orow + lane * 8) = (f32x4){v[0][0], v[0][1], v[0][2], v[0][3]} * rs * g00; *(f32x4*)(orow + lane * 8 + 4) = (f32x4){v[0][4], v[0][5], v[0][6], v[0][7]} * rs * g01;
                *(f32x4*)(orow + (lane + 64) * 8) = (f32x4){v[1][0], v[1][1], v[1][2], v[1][3]} * rs * g10; *(f32x4*)(orow + (lane + 64) * 8 + 4) = (f32x4){v[1][4], v[1][5], v[1][6], v[1][7]} * rs * g11; }
        }
    }
#undef P0_DECODE
#undef IN
#undef SEAM
#undef KARG
#undef ws
#undef ctl
#undef CNT
#undef W_IN
#undef W_UQ
#undef W_UKV
#undef W_OUT
#undef W_MQ
#undef W_MKV
#undef W_MO
#undef W_R
#undef W_GU
#undef W_DN
#undef RCOS
#undef SSQM
#undef SSQ1
#undef SSQ2
#undef SSQQ
#undef SSQKV
#undef KC
#undef VC
#undef MEMN
#undef WTS
#undef RS2
#undef MISCF
#undef LIST
#undef XN
#undef MIX
#undef HB
#undef QD
#undef KD
#undef VD
#undef X1B
#undef QC
#undef CQ
#undef CKV
#undef QM
#undef KM
#undef VM
#undef X2B
#undef OC
#undef YB
#undef RSIN
#undef xin
#undef mem
#undef positions
#undef norm_mix_g
#undef w_in
#undef lq1
#undef lk1
#undef lq2
#undef lk2
#undef diff_out_g
#undef mla_q_norm_g
#undef w_mla_uq
#undef mla_kv_norm_g
#undef w_mla_ukv
#undef mla_out_g
#undef w_out
#undef norm_cross_g
#undef norm_mem_g
#undef w_mem_q
#undef w_mem_kv
#undef w_mem_o
#undef norm_ffn_g
#undef w_group_router
#undef b_group_router
#undef w_expert_router
#undef b_expert_router
#undef w_expert_gate
#undef w_expert_up
#undef w_expert_down
#undef norm_final_g
}

extern "C" void kernel_launch(void* const* d_in, const int* in_sizes, int n_in, void* d_out, int out_size, void* d_ws, size_t ws_size, hipStream_t stream) {
    static int grid = 0;
    if (grid == 0) {
        if (n_in != 30 || out_size != T * DM || ws_size < WS_END) { fprintf(stderr, "kernel_launch: unexpected shapes (n_in %d, out %d, ws %zu)\n", n_in, out_size, ws_size); grid = -1; return; }
        int dev = 0, cus = 0, per_cu = 0;
        if (hipGetDevice(&dev) != hipSuccess || hipDeviceGetAttribute(&cus, hipDeviceAttributeMultiprocessorCount, dev) != hipSuccess) { grid = -1; return; }
        if (hipFuncSetAttribute((const void*)mega_fwd, hipFuncAttributeMaxDynamicSharedMemorySize, LDS_BYTES) != hipSuccess) { fprintf(stderr, "kernel_launch: hipFuncSetAttribute failed\n"); grid = -1; return; }
        if (hipOccupancyMaxActiveBlocksPerMultiprocessor(&per_cu, (const void*)mega_fwd, NWAVES * 64, LDS_BYTES) != hipSuccess || per_cu < 1) { fprintf(stderr, "kernel_launch: occupancy query reports %d\n", per_cu); }
        (void)hipGetLastError();
        if (cus < 256) { fprintf(stderr, "kernel_launch: built for a 256-CU MI355X (got %d CUs)\n", cus); grid = -1; return; }
        grid = cus;
    }
    if (grid < 0) return;
    if (hipMemsetAsync((char*)d_ws + WS_CTL, 0, CTL_ZERO_BYTES, stream) != hipSuccess) return;
    Args a{};
    for (int i = 0; i < 30; ++i) a.in[i] = d_in[i];
    a.out = (float*)d_out; a.ws = (unsigned char*)d_ws; a.reps = PROBE_PH; a.pad_ = 0;
#if MK_N_LAUNCHES == 1
    a.ph_lo = 0; a.ph_hi = N_PHASES;
    hipLaunchKernelGGL(mega_fwd, dim3(grid), dim3(NWAVES * 64), LDS_BYTES, stream, a);
#else
    for (int p = 0; p < N_PHASES; ++p) { a.ph_lo = p; a.ph_hi = p + 1; hipLaunchKernelGGL(mega_fwd, dim3(grid), dim3(NWAVES * 64), LDS_BYTES, stream, a); }
#endif
}
```

```cpp
#include <hip/hip_runtime.h>
#include <cstdio>
#include <cstdint>

#define LAS __attribute__((address_space(3)))
#define GAS __attribute__((address_space(1)))
typedef unsigned short bf16;
typedef short bf16x8 __attribute__((ext_vector_type(8)));
typedef short s16x4 __attribute__((ext_vector_type(4)));
typedef float f32x4 __attribute__((ext_vector_type(4)));
typedef float f32x2 __attribute__((ext_vector_type(2)));
typedef float f32x16 __attribute__((ext_vector_type(16)));
typedef unsigned u32x4 __attribute__((ext_vector_type(4)));
typedef unsigned u32x2 __attribute__((ext_vector_type(2)));
typedef __bf16 bf16x2_t __attribute__((ext_vector_type(2)));

constexpr int NB = 4, SEQ = 8192, DM = 1024, T = NB * SEQ;
constexpr int NMEM = 256;
constexpr int INW = 1952, INWP = 2048;
constexpr int NEXP = 32, EFF = 256;
constexpr float EPS = 1e-6f;
constexpr float LOG2E = 1.4426950408889634f;
constexpr float QS_D = 0.17677669529663687f * LOG2E;
constexpr float QS_M = 0.10206207261596577f * LOG2E;
constexpr float QS_C = 0.08838834764831845f * LOG2E;
constexpr float LAMBDA_INIT = 0.2f;

constexpr size_t MiB = 1u << 20;
constexpr size_t WS_CTL = 0, CTL_ZERO_BYTES = 1 * MiB;
constexpr size_t WS_WIN = 1 * MiB;
constexpr size_t WS_WUQ = 5 * MiB;
constexpr size_t WS_WUKV = 5 * MiB + 512 * 1024;
constexpr size_t WS_WOUT = 6 * MiB;
constexpr size_t WS_WMQ = 8 * MiB;
constexpr size_t WS_WMKV = 9 * MiB;
constexpr size_t WS_WMO = 11 * MiB;
constexpr size_t WS_WR = 12 * MiB;
constexpr size_t WS_WGU = 13 * MiB;
constexpr size_t WS_WDN = 45 * MiB;
constexpr size_t WS_ROPE = 61 * MiB;
constexpr size_t WS_SSQM = 65 * MiB;
constexpr size_t WS_SSQ1 = 66 * MiB;
constexpr size_t WS_SSQ2 = 68 * MiB;
constexpr size_t WS_SSQQ = 70 * MiB;
constexpr size_t WS_SSQKV = 70 * MiB + 512 * 1024;
constexpr size_t WS_KC = 71 * MiB;
constexpr size_t WS_VC = 72 * MiB;
constexpr size_t WS_MEMN = 73 * MiB;
constexpr size_t WS_WT = 75 * MiB;
constexpr size_t WS_RS2 = 75 * MiB + 512 * 1024;
constexpr size_t WS_MISC = 76 * MiB;
constexpr size_t WS_UTAB = 76 * MiB + 4096;
constexpr size_t WS_POS = 76 * MiB + 65536;
constexpr size_t WS_LIST = 77 * MiB;
constexpr size_t WS_A0 = 84 * MiB;
constexpr size_t WS_QD = 148 * MiB, WS_KD = 180 * MiB, WS_VD = 212 * MiB;
constexpr size_t WS_X1B = 148 * MiB;
constexpr size_t WS_QC = 212 * MiB;
constexpr size_t WS_X2Q = 212 * MiB;
constexpr size_t WS_CQ = 244 * MiB;
constexpr size_t WS_CKV = 260 * MiB;
constexpr size_t WS_QM = 268 * MiB;
constexpr size_t WS_KM = 316 * MiB;
constexpr size_t WS_VM = 364 * MiB;
constexpr size_t WS_X2B = 268 * MiB;
constexpr size_t WS_OC = 332 * MiB;
constexpr size_t WS_X1Q = 364 * MiB;
constexpr size_t WS_Y = 120 * MiB;
constexpr size_t WS_MIX = 396 * MiB;
constexpr size_t WS_RS0 = 76 * MiB + 327680;
constexpr size_t WS_END = 460 * MiB;
constexpr int CW_BAR = 4096;
constexpr int CW_KMAX = 8192;
constexpr int CW_QHEAD = 8448;
constexpr int CW_CNT = 16384;

constexpr int RING_BYTES = 131072;
constexpr int ROUTER_LDS = 2 * 36 * 2064;
constexpr int LDSCTL_OFF = 149504, MISC_OFF = LDSCTL_OFF + 64;
constexpr int TP_OFF = LDSCTL_OFF + 256;
constexpr int LDS_BYTES = 150528;
constexpr int NWAVES = 8;

__device__ __forceinline__ unsigned cvtpk(float lo, float hi) { f32x2 v = {lo, hi}; bf16x2_t b = __builtin_convertvector(v, bf16x2_t); return __builtin_bit_cast(unsigned, b); }
__device__ __forceinline__ float bf_lo(unsigned u) { return __uint_as_float(u << 16); }
__device__ __forceinline__ float bf_hi(unsigned u) { return __uint_as_float(u & 0xffff0000u); }
__device__ __forceinline__ unsigned f2bf(float f) { return cvtpk(f, 0.f) & 0xffffu; }
__device__ __forceinline__ float wave_sum(float v) {
#pragma unroll
    for (int o = 1; o < 64; o <<= 1) v += __shfl_xor(v, o);
    return v;
}
#define LDS_WAIT() asm volatile("s_waitcnt lgkmcnt(0)" ::: "memory")
#define VM_WAIT() asm volatile("s_waitcnt vmcnt(0)" ::: "memory")

#define XB_TMO      128
#define XB_XCNT(j)  (256  + 64 * (j))
#define XB_XSUB(j)  (1280 + 64 * (j))
#define XB_XGEN(j)  (2304 + 64 * (j))
#define XB_TOP      3328
#define XB_TOPGEN   3392
#define XCD_BAR_WORDS 3456
#define XB_SPIN_CAP (1u << 18)
__device__ __forceinline__ unsigned xb_ld(unsigned* p)              { return __hip_atomic_load(p, __ATOMIC_RELAXED, __HIP_MEMORY_SCOPE_AGENT); }
__device__ __forceinline__ unsigned xb_add(unsigned* p, unsigned v) { return __hip_atomic_fetch_add(p, v, __ATOMIC_RELAXED, __HIP_MEMORY_SCOPE_AGENT); }
__device__ __forceinline__ unsigned xb_xcc_id() { return (unsigned)__builtin_amdgcn_s_getreg((3 << 11) | 20) & 0xFu; }
#define XB_SPIN(cond, bar) do { unsigned _sp = 0; while (cond) { __builtin_amdgcn_s_sleep(1); \
    if ((++_sp & 255u) == 0u) { if (xb_ld(&(bar)[XB_TMO])) break; if (_sp > XB_SPIN_CAP) { atomicAdd(&(bar)[XB_TMO], 1u); break; } } } } while (0)
struct XcdBarrier { unsigned* bar; unsigned x; volatile LAS unsigned* st; };
__device__ __forceinline__ XcdBarrier xcd_barrier_post(unsigned* bar, volatile LAS unsigned* st) {
    XcdBarrier b; b.bar = bar; b.x = xb_xcc_id(); b.st = st;
    if (threadIdx.x == 0) (void)xb_add(&bar[XB_XCNT(b.x)], 1u);
    return b;
}
__device__ __forceinline__ void xcd_barrier_complete(unsigned* bar, unsigned x, unsigned& nloc, unsigned& nx) {
    const unsigned G = gridDim.x * gridDim.y * gridDim.z;
    unsigned sum, cnt, mine, sp = 0u;
    for (;;) {
        sum = 0u; cnt = 0u; mine = 0u;
#pragma unroll
        for (unsigned j = 0; j < 16; ++j) { const unsigned c = xb_ld(&bar[XB_XCNT(j)]); sum += c; cnt += (c > 0u) ? 1u : 0u; mine = (j == x) ? c : mine; }
        if (sum == G) break;
        __builtin_amdgcn_s_sleep(1);
        if ((++sp & 255u) == 0u) { if (xb_ld(&bar[XB_TMO])) break; if (sp > XB_SPIN_CAP) { atomicAdd(&bar[XB_TMO], 1u); break; } }
    }
    nloc = mine > 0u ? mine : 1u; nx = cnt > 0u ? cnt : 1u;
}
__device__ __forceinline__ void xcd_barrier(const XcdBarrier& b) {
    asm volatile("s_waitcnt vmcnt(0)" ::: "memory");
    __syncthreads();
    if (threadIdx.x == 0) {
        unsigned* bar = b.bar;
        __builtin_amdgcn_s_waitcnt(0);
        unsigned nloc = b.st[0], nx = b.st[1];
        if (nloc == 0u) { xcd_barrier_complete(bar, b.x, nloc, nx); b.st[0] = nloc; b.st[1] = nx; }
        const unsigned old = xb_add(&bar[XB_XSUB(b.x)], 1u);
        const unsigned gen = old / nloc;
        if (old + 1u == (gen + 1u) * nloc) {
            __builtin_amdgcn_fence(__ATOMIC_RELEASE, "agent");
            asm volatile("s_waitcnt vmcnt(0)" ::: "memory");
            const unsigned og = xb_add(&bar[XB_TOP], 1u);
            const unsigned tg = og / nx;
            if (og + 1u == (tg + 1u) * nx) xb_add(&bar[XB_TOPGEN], 1u);
            else XB_SPIN(xb_ld(&bar[XB_TOPGEN]) == tg, bar);
            __builtin_amdgcn_fence(__ATOMIC_ACQUIRE, "agent");
            xb_add(&bar[XB_XGEN(b.x)], 1u);
            asm volatile("s_waitcnt vmcnt(0)" ::: "memory");
        } else {
            XB_SPIN(xb_ld(&bar[XB_XGEN(b.x)]) == gen, bar);
            __builtin_amdgcn_fence(__ATOMIC_ACQUIRE, "agent");
            asm volatile("s_waitcnt vmcnt(0)" ::: "memory");
        }
    }
    __syncthreads();
}

namespace pg8 {
constexpr int BM = 256, BK = 64, HALF = 128, HTB = HALF * BK * 2, STAGE_BYTES = 8 * HTB, NXCD = 8, WGM = 8;
__device__ __forceinline__ int lds_byte(int r, int c) { const int st = (r >> 4) * 2 + (c >> 5), rr = r & 15, cc = c & 31, ob = rr * 64 + cc * 2; return st * 1024 + (ob ^ (((ob >> 9) & 1) << 5)); }
__device__ __forceinline__ int perm32(int rho) { const int n = rho >> 4, i = rho & 15; return 8 * (i >> 2) + 4 * n + (i & 3); }
__device__ __forceinline__ void stage_rc(int b, int& R, int& C) { const int st = b / 1024, sb = b % 1024, swz = sb ^ (((sb >> 9) & 1) << 5); R = (st >> 1) * 16 + swz / 64; C = (st & 1) * 32 + (swz % 64) / 2; }

struct Unit { int pm, pn, e, cnt; };

struct DenseOrder {
    static constexpr bool GATHER = false;
    int nM, nN, nwg, G, c, lda; const char* B; int ldb; int eb;
    __device__ void init(int M, int N, int G_, int c_, int lda_, const void* B_, int ldb_, int eb_ = 2) { nM = M / BM; nN = N / BM; nwg = nM * nN; G = G_; c = c_; lda = lda_; B = (const char*)B_; ldb = ldb_; eb = eb_; }
    __device__ __forceinline__ bool next(int i, Unit& u) const {
        const long L = (long)i * G + c; if (L >= nwg) return false;
        int wgid = (int)L; { const int q = nwg / NXCD, r = nwg % NXCD, xcd = wgid % NXCD, off = wgid / NXCD; wgid = (xcd < r ? xcd * (q + 1) : r * (q + 1) + (xcd - r) * q) + off; }
        const int nig = WGM * nN, gid = wgid / nig, fm = gid * WGM, gsz = (nM - fm) < WGM ? (nM - fm) : WGM;
        u.pm = fm + ((wgid % nig) % gsz); u.pn = (wgid % nig) / gsz; u.e = 0; u.cnt = 0; return true;
    }
    __device__ __forceinline__ void a_offs(const Unit&, const int (&)[2], const int (&)[2], unsigned (&)[2][2]) const {}
    __device__ __forceinline__ size_t a_rowtile(const Unit& u) const { return (size_t)u.pm; }
    __device__ __forceinline__ const char* b_ptr(const Unit& u) const { return B + (size_t)u.pn * BM * ldb * eb; }
};
struct OneUnit {
    static constexpr bool GATHER = false;
    int pm, pn; const char* B; int ldb; int eb;
    __device__ __forceinline__ bool next(int i, Unit& u) const { int i0 = i; asm volatile("" : "+s"(i0)); if (i0 != 0) return false; u.pm = pm; u.pn = pn; u.e = 0; u.cnt = 0; return true; }
    __device__ __forceinline__ void a_offs(const Unit&, const int (&)[2], const int (&)[2], unsigned (&)[2][2]) const {}
    __device__ __forceinline__ size_t a_rowtile(const Unit& u) const { return (size_t)u.pm; }
    __device__ __forceinline__ const char* b_ptr(const Unit& u) const { return B + (size_t)u.pn * BM * ldb * eb; }
};
struct RowUnits {
    static constexpr bool GATHER = false;
    int pm, n; const char* B; int ldb; int eb;
    __device__ __forceinline__ bool next(int i, Unit& u) const { int i0 = i; asm volatile("" : "+s"(i0)); if (i0 >= n) return false; int p0 = pm; asm volatile("" : "+s"(p0)); u.pm = p0; u.pn = i0; u.e = 0; u.cnt = 0; return true; }
    __device__ __forceinline__ void a_offs(const Unit&, const int (&)[2], const int (&)[2], unsigned (&)[2][2]) const {}
    __device__ __forceinline__ size_t a_rowtile(const Unit& u) const { return (size_t)u.pm; }
    __device__ __forceinline__ const char* b_ptr(const Unit& u) const { return B + (size_t)u.pn * BM * ldb * eb; }
};
struct InProjOrder {
    static constexpr bool GATHER = false;
    int c; const char* B; int ldb;
    __device__ __forceinline__ bool next(int i, Unit& u) const { int i0 = i; asm volatile("" : "+s"(i0)); if (i0 >= 4 || c >= 256) return false;
        const int p = c >> 7, off = (c >> 5) & 3; const int k = (i0 == 3) ? 3 : ((off % 3) + i0) % 3; u.pm = c & 127; u.pn = p + 2 * k; u.e = 0; u.cnt = 0; return true; }
    __device__ __forceinline__ void a_offs(const Unit&, const int (&)[2], const int (&)[2], unsigned (&)[2][2]) const {}
    __device__ __forceinline__ size_t a_rowtile(const Unit& u) const { return (size_t)u.pm; }
    __device__ __forceinline__ const char* b_ptr(const Unit& u) const { return B + (size_t)u.pn * BM * ldb * 2; }
};
template <bool GATHER_> struct MoeOrder {
    static constexpr bool GATHER = GATHER_;
    int G, c, NPN, lda; const char* B; int ldb; size_t bstride; const LAS int* TP; const unsigned* cntw; const int* list; int eb;
    __device__ __forceinline__ bool next(int i, Unit& u) const {
        const int ntile = TP[NEXP]; const long L = (long)i * G + c; if (L >= (long)ntile * NPN) return false;
        const int tile = (int)(L / NPN); u.pn = (int)(L % NPN); u.pm = tile;
        int e = 0;
#pragma nounroll
        for (int k = 1; k < NEXP; ++k) e = (TP[k] <= tile) ? k : e;
        u.e = __builtin_amdgcn_readfirstlane(e);
        u.cnt = (int)__builtin_amdgcn_readfirstlane(__hip_atomic_load(cntw + 64 * u.e, __ATOMIC_RELAXED, __HIP_MEMORY_SCOPE_AGENT));
        return true;
    }
    __device__ __forceinline__ void a_offs(const Unit& u, const int (&RA)[2], const int (&CA)[2], unsigned (&off)[2][2]) const {
        if constexpr (!GATHER) return;
        const int j = u.pm - TP[u.e];
#pragma unroll
        for (int h = 0; h < 2; ++h)
#pragma unroll
            for (int i = 0; i < 2; ++i) {
                const int idx = j * BM + h * HALF + RA[i]; const int a = (idx < u.cnt) ? list[(size_t)u.e * T + idx] : 0;
                off[h][i] = (unsigned)((a >> 1) * lda * eb + CA[i] * 2);
            }
    }
    __device__ __forceinline__ size_t a_rowtile(const Unit& u) const { return (size_t)u.pm; }
    __device__ __forceinline__ const char* b_ptr(const Unit& u) const { return B + (size_t)u.e * bstride + (size_t)u.pn * BM * ldb * eb; }
};

template <class Epi, class Sched, bool ALIGN_EPI>
__device__ __forceinline__ void gemm_phase(LAS unsigned char* lds, const char* Abase, int lda, int ldb, int K, const Sched& S, const Epi& E) {
    int tid_ = threadIdx.x; asm volatile("" : "+v"(tid_));
    const int tid = tid_, wid = __builtin_amdgcn_readfirstlane(tid >> 6), lane = tid & 63, wr = wid >> 2, wc = wid & 3, fr = lane & 15, fq = lane >> 4;
    int Kv_ = K; if (K <= 256) asm volatile("" : "+s"(Kv_));
    constexpr int EB = Epi::FP8 ? 1 : 2;
    const int nt = Kv_ / (128 / EB);
    int RA[2], CA[2]; unsigned voffB[2], voffA[2];
#pragma unroll
    for (int i = 0; i < 2; ++i) { int R, C; stage_rc(tid * 16 + i * 8192, R, C); RA[i] = R; CA[i] = C; const int Rb = Epi::PERM ? ((R & ~31) + perm32(R & 31)) : R; voffB[i] = (unsigned)(Rb * ldb * EB + C * 2); voffA[i] = (unsigned)(R * lda * EB + C * 2); }
    const size_t kstep = (size_t)(BK * 2);
    const size_t hstepB = (size_t)HALF * ldb * EB, hstepA = (size_t)HALF * lda * EB, tstepA = 2 * hstepA;
    const unsigned ldsw = (unsigned)wid * 1024u;
    const int aoff = lds_byte(wr * 64 + fr, fq * 8), boff = lds_byte(wc * 32 + fr, fq * 8);
#define PG8_SA(b, h) (((b) * 2 + (h)) * HTB)
#define PG8_SB(b, h) ((4 + (b) * 2 + (h)) * HTB)
#define PG8_STAGE_B(bufoff, gbase) do { _Pragma("unroll") for (int _i = 0; _i < 2; ++_i) \
        __builtin_amdgcn_global_load_lds((const unsigned*)((const char*)(gbase) + voffB[_i]), (LAS unsigned*)(lds + (bufoff) + ldsw + _i * 8192), 16, 0, 0); } while (0)
#define PG8_GL(src, bufoff) __builtin_amdgcn_global_load_lds((const unsigned*)(src), (LAS unsigned*)(lds + (bufoff) + ldsw + _i * 8192), 16, 0, 0)
#define PG8_STAGE_A(bufoff, h, nx, kb) do { \
        if constexpr (Sched::GATHER) { if (nx) { _Pragma("unroll") for (int _i = 0; _i < 2; ++_i) PG8_GL(Abase + (kb) + oAn[h][_i], bufoff); } \
                                       else    { _Pragma("unroll") for (int _i = 0; _i < 2; ++_i) PG8_GL(Abase + (kb) + oAc[h][_i], bufoff); } } \
        else { const char* _b = ((nx) ? nA : cA) + (h) * hstepA + (kb); _Pragma("unroll") for (int _i = 0; _i < 2; ++_i) PG8_GL(_b + voffA[_i], bufoff); } } while (0)
#define PG8_LDA(dst, b, h) do { _Pragma("unroll") for (int m = 0; m < 4; ++m) { if constexpr (Epi::FP8) { dst##8[m].lo = *(const LAS v4i_t*)(lds + PG8_SA(b, h) + aoff + m * 2048); dst##8[m].hi = *(const LAS v4i_t*)(lds + PG8_SA(b, h) + aoff + m * 2048 + 1024); } \
        else { _Pragma("unroll") for (int k = 0; k < 2; ++k) dst[m][k] = *(const LAS bf16x8*)(lds + PG8_SA(b, h) + aoff + m * 2048 + k * 1024); } } } while (0)
#define PG8_LDB(dst, b, h) do { _Pragma("unroll") for (int n = 0; n < 2; ++n) { if constexpr (Epi::FP8) { dst##8[n].lo = *(const LAS v4i_t*)(lds + PG8_SB(b, h) + boff + n * 2048); dst##8[n].hi = *(const LAS v4i_t*)(lds + PG8_SB(b, h) + boff + n * 2048 + 1024); } \
        else { _Pragma("unroll") for (int k = 0; k < 2; ++k) dst[n][k] = *(const LAS bf16x8*)(lds + PG8_SB(b, h) + boff + n * 2048 + k * 1024); } } } while (0)
#define PG8_MMA(ai, bj, At, Bt) do { __builtin_amdgcn_s_setprio(1); _Pragma("unroll") for (int m = 0; m < 4; ++m) _Pragma("unroll") for (int n = 0; n < 2; ++n) { \
        if constexpr (Epi::FP8) asm volatile("v_mfma_f32_16x16x128_f8f6f4 %0, %1, %2, %0" : "+v"(acc[ai][bj][m][n]) : "v"(Bt##8[n]), "v"(At##8[m]));     \
        else { _Pragma("unroll") for (int k = 0; k < 2; ++k) acc[ai][bj][m][n] = __builtin_amdgcn_mfma_f32_16x16x32_bf16(Bt[n][k], At[m][k], acc[ai][bj][m][n], 0, 0, 0); } } \
        __builtin_amdgcn_s_setprio(0); } while (0)
#define PG8_WAIT_V(n) asm volatile("s_waitcnt vmcnt(" #n ")" ::: "memory")
#define PG8_WAIT_L(n) asm volatile("s_waitcnt lgkmcnt(" #n ")" ::: "memory")
#define PG8_BAR __builtin_amdgcn_s_barrier()
#define PG8_SCHED __builtin_amdgcn_sched_barrier(0)
    Unit cur, nxt; int ui = 0;
    if (!S.next(0, cur)) return;
    f32x4 acc[2][2][4][2];
#pragma unroll
    for (int a = 0; a < 2; ++a)
#pragma unroll
        for (int b = 0; b < 2; ++b)
#pragma unroll
            for (int m = 0; m < 4; ++m)
#pragma unroll
                for (int n = 0; n < 2; ++n) acc[a][b][m][n] = (f32x4){0.f, 0.f, 0.f, 0.f};
    typedef int v8i_t __attribute__((ext_vector_type(8))); typedef int v4i_t __attribute__((ext_vector_type(4)));
    bf16x8 At[4][2], B0[2][2], B1[2][2]; v8i_t At8[4], B08[2], B18[2];
    float rsv[8];
    if constexpr (Epi::KROT > 0) E.preload(cur, wr, fr, rsv);
#define PG8_KO(x) ((Epi::KROT > 0) ? (size_t)(((x) + Epi::KROT) & (nt - 1)) * kstep : (size_t)(x) * kstep)
    unsigned oAc[2][2], oAn[2][2];
    S.a_offs(cur, RA, CA, oAc);
    const char* cB = S.b_ptr(cur); const char* cA = Abase + S.a_rowtile(cur) * tstepA; const char* nA = cA;
    PG8_STAGE_B(PG8_SB(0, 0), cB + PG8_KO(0)); PG8_STAGE_B(PG8_SB(0, 1), cB + hstepB + PG8_KO(0)); PG8_STAGE_A(PG8_SA(0, 0), 0, false, PG8_KO(0)); PG8_STAGE_A(PG8_SA(0, 1), 1, false, PG8_KO(0));
    if (wr == 1) PG8_BAR;
    PG8_WAIT_V(2); PG8_BAR;
    PG8_STAGE_B(PG8_SB(1, 0), cB + PG8_KO(1)); PG8_STAGE_A(PG8_SA(1, 0), 0, false, PG8_KO(1)); PG8_STAGE_B(PG8_SB(1, 1), cB + hstepB + PG8_KO(1));
    PG8_WAIT_V(6); PG8_BAR;
    for (;;) {
        const bool has_next = S.next(ui + 1, nxt);
        const char* nB = cB; nA = cA;
        if (has_next) { S.a_offs(nxt, RA, CA, oAn); nB = S.b_ptr(nxt); nA = Abase + S.a_rowtile(nxt) * tstepA; }
        else if constexpr (Sched::GATHER) {
#pragma unroll
            for (int h = 0; h < 2; ++h)
#pragma unroll
                for (int i = 0; i < 2; ++i) oAn[h][i] = oAc[h][i];
        }
#pragma nounroll
        for (int t = 0; t < nt; t += 2) {
            const bool last = (t == nt - 2);
            const size_t ka1 = PG8_KO(t + 1);
            const size_t ka2 = last ? PG8_KO(0) : PG8_KO(t + 2), ka3 = last ? PG8_KO(1) : PG8_KO(t + 3);
            const char* b2 = (last ? nB : cB) + ka2; const char* b3 = (last ? nB : cB) + ka3;
            if constexpr (Epi::KROT > 0) { if (t == nt - Epi::KROT) E.midk(acc, rsv); }
            PG8_LDB(B0, 0, 0); PG8_LDB(B1, 0, 1); PG8_SCHED; PG8_LDA(At, 0, 0); PG8_STAGE_A(PG8_SA(1, 1), 1, false, ka1);
            PG8_WAIT_V(8); PG8_WAIT_L(0); PG8_BAR; PG8_MMA(0, 0, At, B0); PG8_MMA(0, 1, At, B1); PG8_BAR; PG8_SCHED;
            PG8_LDA(At, 0, 1); PG8_STAGE_B(PG8_SB(0, 0), b2); PG8_STAGE_B(PG8_SB(0, 1), b2 + hstepB); PG8_STAGE_A(PG8_SA(0, 0), 0, last, ka2);
            PG8_WAIT_V(8); PG8_WAIT_L(0); PG8_BAR; PG8_MMA(1, 0, At, B0); PG8_MMA(1, 1, At, B1); PG8_BAR; PG8_SCHED;
            PG8_LDB(B0, 1, 0); PG8_LDB(B1, 1, 1); PG8_SCHED; PG8_LDA(At, 1, 0); PG8_STAGE_A(PG8_SA(0, 1), 1, last, ka2);
            PG8_WAIT_V(8); PG8_WAIT_L(0); PG8_BAR; PG8_MMA(0, 0, At, B0); PG8_MMA(0, 1, At, B1); PG8_BAR; PG8_SCHED;
            PG8_LDA(At, 1, 1); PG8_STAGE_B(PG8_SB(1, 0), b3); PG8_STAGE_B(PG8_SB(1, 1), b3 + hstepB); PG8_STAGE_A(PG8_SA(1, 0), 0, last, ka3);
            PG8_WAIT_V(8); PG8_WAIT_L(0); PG8_BAR; PG8_MMA(1, 0, At, B0); PG8_MMA(1, 1, At, B1); PG8_BAR; PG8_SCHED;
        }
        if constexpr (ALIGN_EPI) { if (wr == 0) PG8_BAR; }
        if constexpr (Epi::FP8) asm volatile("s_nop 15\n\ts_nop 15" ::: "memory");
        E(acc, cur, wr, wc, fr, fq);
        if (!has_next) break;
#pragma unroll
        for (int a = 0; a < 2; ++a)
#pragma unroll
            for (int b = 0; b < 2; ++b)
#pragma unroll
                for (int m = 0; m < 4; ++m)
#pragma unroll
                    for (int n = 0; n < 2; ++n) acc[a][b][m][n] = (f32x4){0.f, 0.f, 0.f, 0.f};
        cur = nxt; cB = nB; cA = nA; ++ui;
        if constexpr (Epi::KROT > 0) E.preload(cur, wr, fr, rsv);
        if constexpr (Sched::GATHER) {
#pragma unroll
            for (int h = 0; h < 2; ++h)
#pragma unroll
                for (int i = 0; i < 2; ++i) oAc[h][i] = oAn[h][i];
        }
        if constexpr (ALIGN_EPI) { if (wr == 1) PG8_BAR; }
    }
    PG8_WAIT_V(0);
    if constexpr (!ALIGN_EPI) { if (wr == 0) PG8_BAR; }
    PG8_BAR;
#undef PG8_KO
#undef PG8_SA
#undef PG8_SB
#undef PG8_STAGE_A
#undef PG8_GL
#undef PG8_STAGE_B
#undef PG8_LDA
#undef PG8_LDB
#undef PG8_MMA
#undef PG8_WAIT_V
#undef PG8_WAIT_L
#undef PG8_BAR
#undef PG8_SCHED
}

typedef f32x4 Acc[2][2][4][2];
#define EPI_ROWS(ai, m) ((ai) * HALF + wr * 64 + (m) * 16 + fr)
#define EPI_COL(bj, n) ((bj) * HALF + wc * 32 + (n) * 16 + 4 * fq)
__device__ __forceinline__ void st4(bf16* p, f32x4 v) { u32x2 w; w.x = cvtpk(v[0], v[1]); w.y = cvtpk(v[2], v[3]); *(u32x2*)p = w; }
#define EPI_COLP(bj) ((bj) * HALF + wc * 32 + 8 * fq)
__device__ __forceinline__ void st16_wt(void* p, u32x4 w) { asm volatile("global_store_dwordx4 %0, %1, off sc1\n\ts_nop 1" :: "v"(p), "v"(w)); }
__device__ __forceinline__ void st8(bf16* p, f32x4 a, f32x4 b) { u32x4 w; w.x = cvtpk(a[0], a[1]); w.y = cvtpk(a[2], a[3]); w.z = cvtpk(b[0], b[1]); w.w = cvtpk(b[2], b[3]); *(u32x4*)p = w; }
__device__ __forceinline__ void st8w(bf16* p, f32x4 a, f32x4 b) { u32x4 w; w.x = cvtpk(a[0], a[1]); w.y = cvtpk(a[2], a[3]); w.z = cvtpk(b[0], b[1]); w.w = cvtpk(b[2], b[3]); st16_wt(p, w); }
__device__ __forceinline__ float sq4(f32x4 v) { return (v[0] * v[0] + v[1] * v[1]) + (v[2] * v[2] + v[3] * v[3]); }

struct EpiInProj {
    static constexpr bool PERM = true; static constexpr int KROT = 0; static constexpr bool FP8 = false;
    bf16 *QD, *KD, *VD, *CQ, *CKV, *KM; float *SSQQ, *SSQKV; const float *rcos, *rsin; unsigned* kmaxw;
    __device__ __forceinline__ void operator()(const Acc& acc, const Unit& u, int wr, int wc, int fr, int fq) const {
        const int pn = u.pn;
        if (pn < 6) {
            bf16* base = QD + (size_t)(pn >> 1) * ((WS_KD - WS_QD) / 2); const float sc = pn < 2 ? QS_D : 1.f; const int cb = (pn & 1) * BM;
#pragma unroll
            for (int ai = 0; ai < 2; ++ai)
#pragma unroll
                for (int m = 0; m < 4; ++m) { bf16* rowp = base + (size_t)(u.pm * BM + EPI_ROWS(ai, m)) * 512 + cb;
#pragma unroll
                    for (int bj = 0; bj < 2; ++bj) st8(rowp + EPI_COLP(bj), acc[ai][bj][m][0] * sc, acc[ai][bj][m][1] * sc); }
            if (pn == 2 || pn == 3) {
#pragma unroll
                for (int bj = 0; bj < 2; ++bj) { float mx = 0.f;
#pragma unroll
                    for (int ai = 0; ai < 2; ++ai)
#pragma unroll
                        for (int m = 0; m < 4; ++m) { float q = sq4(acc[ai][bj][m][0]) + sq4(acc[ai][bj][m][1]); q += __shfl_xor(q, 16); q += __shfl_xor(q, 32); mx = fmaxf(mx, q); }
                    mx = fmaxf(mx, __shfl_xor(mx, 1)); mx = fmaxf(mx, __shfl_xor(mx, 2)); mx = fmaxf(mx, __shfl_xor(mx, 4)); mx = fmaxf(mx, __shfl_xor(mx, 8));
                    const int g32 = (cb + bj * HALF + wc * 32) >> 5;
                    if (fr == 0 && fq == 0) atomicMax(kmaxw + (u.pm >> 5) * 16 + g32, __float_as_uint(mx)); }
            }
        } else if (pn == 6) {
#pragma unroll
            for (int ai = 0; ai < 2; ++ai)
#pragma unroll
                for (int m = 0; m < 4; ++m) { const int row = u.pm * BM + EPI_ROWS(ai, m); bf16* rowp = CQ + (size_t)row * 256; float s = 0.f;
#pragma unroll
                    for (int bj = 0; bj < 2; ++bj) { st8(rowp + EPI_COLP(bj), acc[ai][bj][m][0], acc[ai][bj][m][1]); s += sq4(acc[ai][bj][m][0]) + sq4(acc[ai][bj][m][1]); }
                    s += __shfl_xor(s, 16); s += __shfl_xor(s, 32);
                    if (fq == 0) SSQQ[(size_t)row * 4 + wc] = s; }
        } else {
#pragma unroll
            for (int ai = 0; ai < 2; ++ai)
#pragma unroll
                for (int m = 0; m < 4; ++m) { const int row = u.pm * BM + EPI_ROWS(ai, m); bf16* rowp = CKV + (size_t)row * 128;
                    st8(rowp + EPI_COLP(0), acc[ai][0][m][0], acc[ai][0][m][1]);
                    float s = sq4(acc[ai][0][m][0]) + sq4(acc[ai][0][m][1]);
                    s += __shfl_xor(s, 16); s += __shfl_xor(s, 32);
                    if (fq == 0) SSQKV[(size_t)row * 4 + wc] = s;
                    if (wc == 0) {
                        const f32x4 a0 = acc[ai][1][m][0], a1 = acc[ai][1][m][1]; f32x4 o0, o1;
#pragma unroll
                        for (int q = 0; q < 4; ++q) { o0[q] = __shfl_xor(a0[q], 32); o1[q] = __shfl_xor(a1[q], 32); }
                        const int i0 = 8 * (fq & 1);
                        const f32x4 c0 = *(const f32x4*)(rcos + (size_t)row * 16 + i0), c1 = *(const f32x4*)(rcos + (size_t)row * 16 + i0 + 4);
                        const f32x4 s0 = *(const f32x4*)(rsin + (size_t)row * 16 + i0), s1 = *(const f32x4*)(rsin + (size_t)row * 16 + i0 + 4);
                        const float sg = (fq < 2) ? -1.f : 1.f;
                        const f32x4 r0 = a0 * c0 + o0 * s0 * sg, r1 = a1 * c1 + o1 * s1 * sg;
                        bf16* kp = KM + (size_t)row * 768 + 64 + 8 * fq;
#pragma unroll
                        for (int h = 0; h < 8; ++h) st8(kp + h * 96, r0, r1);
                    }
                    if (m & 1) asm volatile("" ::: "memory"); }
        }
    }
};
struct EpiUpQ {
    static constexpr bool PERM = true; static constexpr int KROT = 0; static constexpr bool FP8 = false;
    bf16* QM; const float* SSQQ; const float *rcos, *rsin;
    __device__ __forceinline__ void operator()(const Acc& acc, const Unit& u, int wr, int wc, int fr, int fq) const {
        float rsv[8];
#pragma unroll
        for (int i = 0; i < 8; ++i) { const f32x4 p = *(const f32x4*)(SSQQ + (size_t)(u.pm * BM + EPI_ROWS(i >> 2, i & 3)) * 4); rsv[i] = __builtin_amdgcn_rsqf(((p[0] + p[1]) + (p[2] + p[3])) * (1.f / 256.f) + EPS) * QS_M; }
#pragma unroll
        for (int i = 0; i < 8; ++i) { const int ai = i >> 2, m = i & 3; const int row = u.pm * BM + EPI_ROWS(ai, m); const float rs = rsv[i];
            bf16* rowp = QM + (size_t)row * 768 + u.pn * BM;
#pragma unroll
            for (int bj = 0; bj < 2; ++bj) { const int g32 = (u.pn * BM + bj * HALF + wc * 32) >> 5;
                f32x4 v0 = acc[ai][bj][m][0] * rs, v1 = acc[ai][bj][m][1] * rs;
                if (g32 % 3 == 2) { f32x4 o0, o1;
#pragma unroll
                    for (int q = 0; q < 4; ++q) { o0[q] = __shfl_xor(v0[q], 32); o1[q] = __shfl_xor(v1[q], 32); }
                    const int i0 = 8 * (fq & 1);
                    const f32x4 c0 = *(const f32x4*)(rcos + (size_t)row * 16 + i0), c1 = *(const f32x4*)(rcos + (size_t)row * 16 + i0 + 4);
                    const f32x4 s0 = *(const f32x4*)(rsin + (size_t)row * 16 + i0), s1 = *(const f32x4*)(rsin + (size_t)row * 16 + i0 + 4);
                    const float sg = (fq < 2) ? -1.f : 1.f;
                    v0 = v0 * c0 + o0 * s0 * sg; v1 = v1 * c1 + o1 * s1 * sg; }
                st8(rowp + EPI_COLP(bj), v0, v1); }
            if (i & 1) asm volatile("" ::: "memory"); }
    }
};
struct EpiUpKV {
    static constexpr bool PERM = true; static constexpr int KROT = 0; static constexpr bool FP8 = false;
    bf16 *KM, *VM; const float* SSQKV;
    __device__ __forceinline__ void operator()(const Acc& acc, const Unit& u, int wr, int wc, int fr, int fq) const {
        float rsv[8];
#pragma unroll
        for (int i = 0; i < 8; ++i) { const f32x4 p = *(const f32x4*)(SSQKV + (size_t)(u.pm * BM + EPI_ROWS(i >> 2, i & 3)) * 4); rsv[i] = __builtin_amdgcn_rsqf(((p[0] + p[1]) + (p[2] + p[3])) * (1.f / 128.f) + EPS); }
#pragma unroll
        for (int i = 0; i < 8; ++i) { const int ai = i >> 2, m = i & 3; const int row = u.pm * BM + EPI_ROWS(ai, m); const float rs = rsv[i];
#pragma unroll
            for (int bj = 0; bj < 2; ++bj) { const int head = u.pn * 2 + bj; const int w32 = wc * 32;
                bf16* dst = (w32 < 64) ? KM + (size_t)row * 768 + head * 96 + w32 : VM + (size_t)row * 512 + head * 64 + (w32 - 64);
                st8(dst + 8 * fq, acc[ai][bj][m][0] * rs, acc[ai][bj][m][1] * rs); } }
    }
};
struct EpiMemKV {
    static constexpr bool PERM = true; static constexpr int KROT = 0; static constexpr bool FP8 = false;
    bf16 *KC, *VC;
    __device__ __forceinline__ void operator()(const Acc& acc, const Unit& u, int wr, int wc, int fr, int fq) const {
        bf16* base = KC + (size_t)(u.pn >> 1) * ((WS_VC - WS_KC) / 2); const int cb = (u.pn & 1) * BM;
#pragma unroll
        for (int ai = 0; ai < 2; ++ai)
#pragma unroll
            for (int m = 0; m < 4; ++m) { bf16* rowp = base + (size_t)(u.pm * BM + EPI_ROWS(ai, m)) * 512 + cb;
#pragma unroll
                for (int bj = 0; bj < 2; ++bj) st8(rowp + EPI_COLP(bj), acc[ai][bj][m][0], acc[ai][bj][m][1]); }
    }
};
template <bool RES_F32, int KROT_ = 0, bool FP8_ = false> struct EpiResid {
    static constexpr bool PERM = true; static constexpr int KROT = KROT_; static constexpr bool FP8 = FP8_;
    const float* resf; const bf16* resb; bf16* XO; float* SSQ; const float* ssqm; unsigned char* XQ; float ascale; const float* rscale;
    __device__ __forceinline__ void preload(const Unit& u, int wr, int fr, float (&rsv)[8]) const {
#pragma unroll
        for (int i = 0; i < 8; ++i) { const f32x4* sp = (const f32x4*)(ssqm + (size_t)(u.pm * BM + EPI_ROWS(i >> 2, i & 3)) * 8); const f32x4 a = sp[0] + sp[1]; rsv[i] = __builtin_amdgcn_rsqf(((a[0] + a[1]) + (a[2] + a[3])) * (1.f / 512.f) + EPS); }
    }
    __device__ __forceinline__ void midk(Acc& acc, const float (&rsv)[8]) const {
#pragma unroll
        for (int i = 0; i < 8; ++i)
#pragma unroll
            for (int bj = 0; bj < 2; ++bj)
#pragma unroll
                for (int n = 0; n < 2; ++n) acc[i >> 2][bj][i & 3][n] *= rsv[i];
    }
    __device__ __forceinline__ void operator()(const Acc& acc, const Unit& u, int wr, int wc, int fr, int fq) const {
#pragma unroll
        for (int ai = 0; ai < 2; ++ai)
#pragma unroll
            for (int m = 0; m < 4; ++m) { const int row = u.pm * BM + EPI_ROWS(ai, m); const size_t ro = (size_t)row * DM + u.pn * BM; float s = 0.f;
#pragma unroll
                for (int bj = 0; bj < 2; ++bj) { const int c = EPI_COLP(bj); f32x4 r0, r1;
                    if (RES_F32) { r0 = *(const f32x4*)(resf + ro + c); r1 = *(const f32x4*)(resf + ro + c + 4); }
                    else { const u32x4 w = *(const u32x4*)(resb + ro + c); r0 = (f32x4){bf_lo(w.x), bf_hi(w.x), bf_lo(w.y), bf_hi(w.y)}; r1 = (f32x4){bf_lo(w.z), bf_hi(w.z), bf_lo(w.w), bf_hi(w.w)};
                        if (rscale) { const float q = rscale[row]; r0 = r0 * q; r1 = r1 * q; } }
                    const f32x4 v0 = r0 + acc[ai][bj][m][0] * ascale, v1 = r1 + acc[ai][bj][m][1] * ascale; st8w(XO + ro + c, v0, v1); s += sq4(v0) + sq4(v1);
                    if (!RES_F32 && XQ) { unsigned w0 = 0, w1 = 0; w0 = __builtin_amdgcn_cvt_pk_fp8_f32(v0[0], v0[1], w0, false); w0 = __builtin_amdgcn_cvt_pk_fp8_f32(v0[2], v0[3], w0, true);
                        w1 = __builtin_amdgcn_cvt_pk_fp8_f32(v1[0], v1[1], w1, false); w1 = __builtin_amdgcn_cvt_pk_fp8_f32(v1[2], v1[3], w1, true); *(u32x2*)(XQ + ro + c) = (u32x2){w0, w1}; } }
                s += __shfl_xor(s, 16); s += __shfl_xor(s, 32);
                if (fq == 0) SSQ[(size_t)row * 16 + u.pn * 4 + wc] = s;
                if (m & 1) asm volatile("" ::: "memory"); }
    }
};
struct EpiCrossQ {
    static constexpr bool PERM = true; static constexpr int KROT = 0; static constexpr bool FP8 = false;
    bf16* QC; const float* SSQ1;
    __device__ __forceinline__ void operator()(const Acc& acc, const Unit& u, int wr, int wc, int fr, int fq) const {
        float rsv[8];
#pragma unroll
        for (int hb = 0; hb < 2; ++hb) {
#pragma unroll
            for (int i = 4 * hb; i < 4 * hb + 4; ++i) { const f32x4* pp = (const f32x4*)(SSQ1 + (size_t)(u.pm * BM + EPI_ROWS(i >> 2, i & 3)) * 16); const f32x4 p = (pp[0] + pp[1]) + (pp[2] + pp[3]);
                rsv[i] = __builtin_amdgcn_rsqf(((p[0] + p[1]) + (p[2] + p[3])) * (1.f / 1024.f) + EPS) * QS_C; }
            asm volatile("" ::: "memory"); }
#pragma unroll
        for (int i = 0; i < 8; ++i) { const int ai = i >> 2, m = i & 3; bf16* rowp = QC + (size_t)(u.pm * BM + EPI_ROWS(ai, m)) * 512 + u.pn * BM;
#pragma unroll
            for (int bj = 0; bj < 2; ++bj) st8(rowp + EPI_COLP(bj), acc[ai][bj][m][0] * rsv[i], acc[ai][bj][m][1] * rsv[i]); }
    }
};
struct EpiMoeUp {
    static constexpr bool PERM = false; static constexpr int KROT = 0; static constexpr bool FP8 = true;
    bf16* H; const int* list; const float* RS2; const LAS int* TP;
    __device__ __forceinline__ void operator()(const Acc& acc, const Unit& u, int wr, int wc, int fr, int fq) const {
        const int j = u.pm - TP[u.e];
        int a[8]; float rsv[8];
#pragma unroll
        for (int i = 0; i < 8; ++i) { const int idx = j * BM + EPI_ROWS(i >> 2, i & 3); a[i] = (idx < u.cnt) ? list[(size_t)u.e * T + idx] : 0; }
#pragma unroll
        for (int i = 0; i < 8; ++i) rsv[i] = RS2[a[i] >> 1] * (1.f / 32.f);
#pragma unroll
        for (int i = 0; i < 8; ++i) { const int ai = i >> 2, m = i & 3; const float rs = rsv[i];
            bf16* rowp = H + (size_t)(u.pm * BM + EPI_ROWS(ai, m)) * EFF;
#pragma unroll
            for (int bj = 0; bj < 2; ++bj) { const int g32 = (u.pn * BM + bj * HALF + wc * 32) >> 5;
                const f32x4 g = acc[ai][bj][m][0] * rs, up = acc[ai][bj][m][1] * rs; f32x4 h;
#pragma unroll
                for (int q = 0; q < 4; ++q) h[q] = g[q] * up[q] * __builtin_amdgcn_rcpf(1.f + __builtin_amdgcn_exp2f(-g[q] * LOG2E));
                { unsigned w_ = 0; w_ = __builtin_amdgcn_cvt_pk_fp8_f32(h[0], h[1], w_, false); w_ = __builtin_amdgcn_cvt_pk_fp8_f32(h[2], h[3], w_, true); *(unsigned*)((unsigned char*)H + (size_t)(u.pm * BM + EPI_ROWS(ai, m)) * EFF + 16 * g32 + 4 * fq) = w_; } } }
    }
};
struct EpiMoeDown {
    static constexpr bool PERM = true; static constexpr int KROT = 0; static constexpr bool FP8 = true;
    bf16* Y;
    __device__ __forceinline__ void operator()(const Acc& acc, const Unit& u, int wr, int wc, int fr, int fq) const {
#pragma unroll
        for (int ai = 0; ai < 2; ++ai)
#pragma unroll
            for (int m = 0; m < 4; ++m) {
#pragma unroll
                for (int bj = 0; bj < 2; ++bj) { const f32x4 v0 = acc[ai][bj][m][0] * (1.f / 16.f), v1 = acc[ai][bj][m][1] * (1.f / 16.f); unsigned w0 = 0, w1 = 0;
                    w0 = __builtin_amdgcn_cvt_pk_fp8_f32(v0[0], v0[1], w0, false); w0 = __builtin_amdgcn_cvt_pk_fp8_f32(v0[2], v0[3], w0, true);
                    w1 = __builtin_amdgcn_cvt_pk_fp8_f32(v1[0], v1[1], w1, false); w1 = __builtin_amdgcn_cvt_pk_fp8_f32(v1[2], v1[3], w1, true);
                    *(u32x2*)((unsigned char*)Y + (size_t)(u.pm * BM + EPI_ROWS(ai, m)) * DM + u.pn * BM + EPI_COLP(bj)) = (u32x2){w0, w1}; } }
    }
};
}

namespace att {
typedef short v4i16_t __attribute__((ext_vector_type(4)));
__device__ __forceinline__ int crow(int r, int hi) { return (r & 3) + 8 * (r >> 2) + 4 * hi; }
__device__ __forceinline__ s16x4 vtr(const LAS unsigned char* p) { return __builtin_bit_cast(s16x4, __builtin_amdgcn_ds_read_tr16_b64_v4i16((LAS v4i16_t*)p)); }

template <int DQK, int NMAP, int DV, bool CAUSAL, bool ALIBI, int qpitch, int kpitch, int vpitch, class Epi>
__device__ __forceinline__ void attn_unit(LAS unsigned char* lds, const bf16* Qp, const bf16* Kp, const bf16* Vp, int NT, int qrow0, float cb, const Epi& epi) {
    constexpr int KW = NMAP * DQK, KCH = KW / 8, KROWB = KW * 2 + 16, KTB = 64 * KROWB, VCH = DV / 8, VTB = 64 * DV * 2, NDB = DV / 32, NDK = DQK / 16;
    constexpr int NKC = (64 * KCH + 511) / 512, NVC = (64 * VCH + 511) / 512;
    static_assert(2 * KTB + 2 * VTB <= RING_BYTES, "attention LDS");
    int tid_ = threadIdx.x; asm volatile("" : "+v"(tid_));
    const int tid = tid_, lane = tid & 63, r32 = lane & 31, hi = lane >> 5; const int wid = __builtin_amdgcn_readfirstlane(tid >> 6);
    bf16x8 qf[NMAP][NDK];
    { const bf16* qrow = Qp + (size_t)(wid * 32 + r32) * qpitch;
#pragma unroll
      for (int mp = 0; mp < NMAP; ++mp)
#pragma unroll
          for (int d0 = 0; d0 < NDK; ++d0) qf[mp][d0] = *(const bf16x8*)(qrow + mp * DQK + d0 * 16 + hi * 8); }
    f32x16 O[NMAP][NDB]; float mrun[NMAP], lrun[NMAP];
#pragma unroll
    for (int mp = 0; mp < NMAP; ++mp) { mrun[mp] = -INFINITY; lrun[mp] = 0.f;
#pragma unroll
        for (int db = 0; db < NDB; ++db)
#pragma unroll
            for (int r = 0; r < 16; ++r) O[mp][db][r] = 0.f; }
    int kgo[NKC], klo[NKC], vgo[NVC], vlo[NVC]; bool kval[NKC], vval[NVC];
#pragma unroll
    for (int c = 0; c < NKC; ++c) { const int id = tid + 512 * c; kval[c] = id < 64 * KCH; const int row = id / KCH, cc = id % KCH; kgo[c] = row * kpitch + cc * 8; klo[c] = row * KROWB + cc * 16; }
#pragma unroll
    for (int c = 0; c < NVC; ++c) { const int id = tid + 512 * c; vval[c] = id < 64 * VCH; const int row = id / VCH, cc = id % VCH; vgo[c] = row * vpitch + cc * 8; vlo[c] = (cc >> 2) * 4096 + row * 64 + (cc & 3) * 16; }
    u32x4 kreg[NKC], vreg[NVC];
#define ATT_LOADG(t) do { _Pragma("unroll") for (int c = 0; c < NKC; ++c) if (kval[c]) kreg[c] = *(const u32x4*)(Kp + (size_t)(t) * 64 * kpitch + kgo[c]); \
        _Pragma("unroll") for (int c = 0; c < NVC; ++c) if (vval[c]) vreg[c] = *(const u32x4*)(Vp + (size_t)(t) * 64 * vpitch + vgo[c]); } while (0)
#define ATT_STORE(b) do { _Pragma("unroll") for (int c = 0; c < NKC; ++c) if (kval[c]) *(LAS u32x4*)(lds + (b) * KTB + klo[c]) = kreg[c]; \
        _Pragma("unroll") for (int c = 0; c < NVC; ++c) if (vval[c]) *(LAS u32x4*)(lds + 2 * KTB + (b) * VTB + vlo[c]) = vreg[c]; } while (0)
    ATT_LOADG(0); ATT_STORE(0); __syncthreads();
    const int afirst = qrow0 + wid * 32;
    float cbr[16];
#pragma unroll
    for (int r = 0; r < 16; ++r) cbr[r] = ALIBI ? cb * (float)crow(r, hi) : 0.f;
    const int vlane = (4 * hi + ((lane & 15) >> 2)) * 64 + (((lane >> 4) & 1) * 16 + (lane & 3) * 4) * 2;
    for (int t = 0; t < NT; ++t) {
        const int cur = t & 1;
        if (t + 1 < NT) ATT_LOADG(t + 1);
        const bool active = !CAUSAL || (64 * t <= afirst);
        if (active) {
            const LAS unsigned char* kb_ = lds + cur * KTB + r32 * KROWB + hi * 16;
            const LAS unsigned char* vb_ = lds + 2 * KTB + cur * VTB + vlane;
            const bool diag = CAUSAL && (64 * t + 63 > afirst);
#pragma unroll
            for (int mp = 0; mp < NMAP; ++mp) {
                f32x16 s[2];
#pragma unroll
                for (int kb = 0; kb < 2; ++kb) {
                    f32x16 a;
                    if (ALIBI) { const float tb = cb * (float)(64 * t + 32 * kb - qrow0 - 255);
#pragma unroll
                        for (int r = 0; r < 16; ++r) a[r] = cbr[r] + tb; }
                    else {
#pragma unroll
                        for (int r = 0; r < 16; ++r) a[r] = 0.f; }
#pragma unroll
                    for (int d0 = 0; d0 < NDK; ++d0) { const bf16x8 kf = *(const LAS bf16x8*)(kb_ + kb * 32 * KROWB + (mp * DQK + d0 * 16) * 2); a = __builtin_amdgcn_mfma_f32_32x32x16_bf16(kf, qf[mp][d0], a, 0, 0, 0); }
                    s[kb] = a; __builtin_amdgcn_sched_barrier(0);
                }
                if (diag) { int qi = afirst + r32; asm volatile("" : "+v"(qi));
#pragma unroll
                    for (int kb = 0; kb < 2; ++kb)
#pragma unroll
                        for (int r = 0; r < 16; ++r) { const int kj = 64 * t + 32 * kb + crow(r, hi); if (kj > qi) s[kb][r] = -INFINITY; } }
                float mx = fmaxf(s[0][0], s[1][0]);
#pragma unroll
                for (int r = 1; r < 16; ++r) mx = fmaxf(mx, fmaxf(s[0][r], s[1][r]));
                mx = fmaxf(mx, __shfl_xor(mx, 32));
                const float mnew = fmaxf(mrun[mp], mx);
                if (__any(mnew > mrun[mp])) {
                    const float alpha = __builtin_amdgcn_exp2f(mrun[mp] - mnew);
                    lrun[mp] *= alpha;
#pragma unroll
                    for (int db = 0; db < NDB; ++db)
#pragma unroll
                        for (int r = 0; r < 16; ++r) O[mp][db][r] *= alpha;
                    mrun[mp] = mnew;
                }
                float ls = 0.f;
#pragma unroll
                for (int kb = 0; kb < 2; ++kb)
#pragma unroll
                    for (int r = 0; r < 16; ++r) { const float p = __builtin_amdgcn_exp2f(s[kb][r] - mnew); s[kb][r] = p; ls += p; }
                lrun[mp] += ls;
#pragma unroll
                for (int s4 = 0; s4 < 4; ++s4) {
                    const int kb = s4 >> 1, hf = (s4 & 1) * 8;
                    u32x4 pw; pw.x = cvtpk(s[kb][hf + 0], s[kb][hf + 1]); pw.y = cvtpk(s[kb][hf + 2], s[kb][hf + 3]); pw.z = cvtpk(s[kb][hf + 4], s[kb][hf + 5]); pw.w = cvtpk(s[kb][hf + 6], s[kb][hf + 7]);
                    const bf16x8 pf = __builtin_bit_cast(bf16x8, pw);
#pragma unroll
                    for (int db = 0; db < NDB; ++db) {
                        const s16x4 lo = vtr(vb_ + db * 4096 + s4 * 1024), hh = vtr(vb_ + db * 4096 + s4 * 1024 + 512);
                        const bf16x8 vf = (bf16x8){lo[0], lo[1], lo[2], lo[3], hh[0], hh[1], hh[2], hh[3]};
                        O[mp][db] = __builtin_amdgcn_mfma_f32_32x32x16_bf16(vf, pf, O[mp][db], 0, 0, 0);
                    }
                }
            }
        }
        if (t + 1 < NT) ATT_STORE(cur ^ 1);
        __syncthreads();
    }
#undef ATT_LOADG
#undef ATT_STORE
    float ltot[NMAP];
#pragma unroll
    for (int mp = 0; mp < NMAP; ++mp) ltot[mp] = lrun[mp] + __shfl_xor(lrun[mp], 32);
    epi(O, ltot, wid * 32 + r32, r32, hi);
}
}


namespace att2 {
#define A2_SBAR() __builtin_amdgcn_sched_barrier(0)
typedef short v4i16_t __attribute__((ext_vector_type(4)));
__device__ __forceinline__ float max3f(float a, float b, float c) { float r; asm("v_max3_f32 %0, %1, %2, %3" : "=v"(r) : "v"(a), "v"(b), "v"(c)); return r; }
__device__ __forceinline__ float fadd_s(float a, float b) { float r; asm("v_add_f32_e32 %0, %1, %2" : "=v"(r) : "v"(a), "v"(b)); return r; }
__device__ __forceinline__ float max2f(float a, float b) { float r; asm("v_max_f32_e32 %0, %1, %2" : "=v"(r) : "v"(a), "v"(b)); return r; }
__device__ __forceinline__ int crow(int r, int hi) { return (r & 3) + 8 * (r >> 2) + 4 * hi; }
__device__ __forceinline__ s16x4 vtr(const LAS unsigned char* p) { return __builtin_bit_cast(s16x4, __builtin_amdgcn_ds_read_tr16_b64_v4i16((LAS v4i16_t*)p)); }
__device__ __forceinline__ float xhalf_max(float m) { auto rr = __builtin_amdgcn_permlane32_swap(__float_as_uint(m), __float_as_uint(m), false, false); return max2f(__uint_as_float(rr[0]), __uint_as_float(rr[1])); }
__device__ __forceinline__ float xhalf_sum(float m) { auto rr = __builtin_amdgcn_permlane32_swap(__float_as_uint(m), __float_as_uint(m), false, false); return __uint_as_float(rr[0]) + __uint_as_float(rr[1]); }
__device__ __forceinline__ float rowmax32(const f32x16& p0, const f32x16& p1) {
    float a = max3f(p0[0], p0[1], p1[0]), b = max3f(p0[2], p0[3], p1[1]); a = max3f(a, p1[2], p1[3]);
#pragma unroll
    for (int r = 4; r < 16; r += 4) { a = max3f(a, p0[r], p0[r + 1]); b = max3f(b, p0[r + 2], p0[r + 3]); a = max3f(a, p1[r], p1[r + 1]); b = max3f(b, p1[r + 2], p1[r + 3]); }
    return xhalf_max(max2f(a, b));
}
__device__ __forceinline__ void glds16(const void* gsrc, unsigned lds_dst) { unsigned keep;
    asm volatile("s_mov_b32 %0, m0\n\ts_mov_b32 m0, %2\n\ts_nop 0\n\tglobal_load_lds_dwordx4 %1, off\n\ts_mov_b32 m0, %0" : "=&s"(keep) : "v"(gsrc), "s"(lds_dst) : "memory"); }
#define A2_PIN(x) asm volatile("" :: "v"(x))
constexpr float NEGM = -30000.f, THR = 6.f, SKIP_THR = 28.f;
constexpr int VTB = 8192;

template <int DQK, int NMAP, bool ALIBI, int qpitch, int kpitch, int vpitch, class Epi, int VAR = 0>
__device__ __forceinline__ bool unit(LAS unsigned char* lds, const bf16* Qp, const bf16* Kp, const bf16* Vp, int NT, int qrow0, float cb, float kmax0, float kmax1, const Epi& epi, bool chk = true) {
    constexpr int KW = NMAP * DQK, KCH = KW / 8, KROWB = KW * 2 + 16, KTB = 64 * KROWB, NDK = DQK / 16, NQ = 2 * NDK, KA = (NMAP == 1) ? 2 : 1;
    constexpr int NKS = (NMAP == 1) ? 6 : 3, NVS = (NMAP == 1) ? 4 : 2;
    constexpr int OFF_V = NKS * KTB, OFF_FLAG = OFF_V + NVS * VTB;
    static_assert(OFF_FLAG + 64 <= RING_BYTES, "attention LDS");
    int tid_ = threadIdx.x; asm volatile("" : "+v"(tid_));
    const int tid = tid_, lane = tid & 63, r32 = lane & 31, hi = lane >> 5; const int wid = __builtin_amdgcn_readfirstlane(tid >> 6);
    const int chki = __builtin_amdgcn_readfirstlane((int)chk);
    bf16x8 qf[NMAP][NDK];
    { const bf16* qrow = Qp + (size_t)(wid * 32 + r32) * qpitch;
#pragma unroll
      for (int mp = 0; mp < NMAP; ++mp)
#pragma unroll
          for (int d0 = 0; d0 < NDK; ++d0) qf[mp][d0] = *(const bf16x8*)(qrow + mp * DQK + d0 * 16 + hi * 8); }
    f32x16 O[NMAP][2]; float mhat[NMAP], lsum[NMAP], fres[NMAP];
#pragma unroll
    for (int mp = 0; mp < NMAP; ++mp) { mhat[mp] = 0.f; lsum[mp] = 0.f; fres[mp] = 1.f;
#pragma unroll
        for (int db = 0; db < 2; ++db)
#pragma unroll
            for (int r = 0; r < 16; ++r) O[mp][db][r] = 0.f; }
    float qn[NMAP];
    if (ALIBI) {
#pragma unroll
        for (int mp = 0; mp < NMAP; ++mp) { float ss = 0.f;
#pragma unroll
            for (int d0 = 0; d0 < NDK; ++d0)
#pragma unroll
                for (int j = 0; j < 8; ++j) { const float v = __uint_as_float((unsigned)(unsigned short)qf[mp][d0][j] << 16); ss += v * v; }
            qn[mp] = sqrtf(xhalf_sum(ss)) * ((mp == 0) ? kmax0 : kmax1); }
    }
    constexpr int CPR = KCH + 1, KPIECES = (64 * CPR) / 64;
    int kgo[2];
#pragma unroll
    for (int c = 0; c < 2; ++c) { const int sl = 64 * (wid + 8 * c) + lane, row = sl / CPR, cc = sl % CPR; kgo[c] = row * kpitch + (cc == KCH ? 0 : cc) * 8; }
    const int vgo = (16 * (wid & 3) + (lane >> 2)) * vpitch + (wid >> 2) * 32 + (lane & 3) * 8;
    const unsigned lds0 = (unsigned)(uintptr_t)lds;
#define A2_DMAK(u) do { if (VAR == 2) break; const bf16* kt_ = Kp + (size_t)(NT - 1 - (u)) * 64 * kpitch; const unsigned kd_ = (unsigned)__builtin_amdgcn_readfirstlane((int)(lds0 + ((u) % NKS) * KTB + wid * 1024)); \
        glds16(kt_ + kgo[0], kd_); if (wid + 8 < KPIECES) glds16(kt_ + kgo[1], kd_ + 8192u); } while (0)
#define A2_DMAV(u) if (VAR != 2) glds16(Vp + (size_t)(NT - 1 - (u)) * 64 * vpitch + vgo, (unsigned)__builtin_amdgcn_readfirstlane((int)(lds0 + OFF_V + ((u) % NVS) * VTB + wid * 1024)))
    volatile LAS unsigned* flags = (volatile LAS unsigned*)(lds + OFF_FLAG);
    if (lane == 0) { if (ALIBI) flags[wid] = 0u; flags[8 + wid] = 0u; }
    A2_DMAK(0); A2_DMAV(0); A2_DMAK(1); if (KA == 2) { A2_DMAK(2); A2_DMAK(3); A2_DMAV(1); }
    asm volatile("s_waitcnt vmcnt(0)" ::: "memory"); __syncthreads();
    const LAS unsigned char* kfb = lds + r32 * KROWB + hi * 16;
    const LAS unsigned char* vfb = lds + OFF_V + (4 * hi + ((lane & 15) >> 2)) * 64 + (((lane >> 4) & 1) * 16 + (lane & 3) * 4) * 2;
    const int qrel = wid * 32 + r32;
    f32x16 SA0, SA1, SB0, SB1;
    bf16x8 kf[NQ]; s16x4 vl[8], vh[8]; u32x4 pw[4];
#define A2_EL(X0, X1, e) ((e) < 16 ? X0[(e) & 15] : X1[(e) & 15])
#define A2_VRD(f) do { const LAS unsigned char* p_ = vb_ + ((f) & 1) * 4096 + ((f) >> 1) * 1024; vl[f] = vtr(p_); vh[f] = vtr(p_ + 512); } while (0)
#define A2_KRD1(i, slot, mp) kf[i] = *(const LAS bf16x8*)(kfb + (slot) * KTB + ((i) / NDK) * 32 * KROWB + ((mp) * DQK + ((i) % NDK) * 16) * 2)
#define A2_INIT(X, kb, u, mp) do { if (ALIBI) { const float tb_ = cb * (float)(32 * (kb) - 63 - 64 * (u) + 4 * hi) - mhat[mp]; _Pragma("unroll") for (int r = 0; r < 16; ++r) X[r] = __builtin_fmaf(cb, (float)((r & 3) + 8 * (r >> 2)), tb_); } \
        else { const float nm_ = -mhat[mp]; _Pragma("unroll") for (int r = 0; r < 16; ++r) X[r] = nm_; } } while (0)
#define A2_MASK(X0, X1, u) do { if ((u) < 4) { const int kb_ = 192 - 64 * (u) + 4 * hi; \
        _Pragma("unroll") for (int r = 0; r < 16; ++r) { const int kj = kb_ + (r & 3) + 8 * (r >> 2); if (kj > qrel) X0[r] = NEGM; if (kj + 32 > qrel) X1[r] = NEGM; } } } while (0)
    {
#pragma unroll
        for (int i = 0; i < NQ; ++i) A2_KRD1(i, 0, 0);
        A2_INIT(SA0, 0, 0, 0); A2_INIT(SA1, 1, 0, 0);
#pragma unroll
        for (int d0 = 0; d0 < NDK; ++d0) { SA0 = __builtin_amdgcn_mfma_f32_32x32x16_bf16(kf[d0], qf[0][d0], SA0, 0, 0, 0); SA1 = __builtin_amdgcn_mfma_f32_32x32x16_bf16(kf[NDK + d0], qf[0][d0], SA1, 0, 0, 0); }
        A2_MASK(SA0, SA1, 0);
        const float rm = max2f(rowmax32(SA0, SA1), -10000.f); mhat[0] = rm;
#pragma unroll
        for (int r = 0; r < 16; ++r) { SA0[r] = __builtin_amdgcn_exp2f(SA0[r] - rm); SA1[r] = __builtin_amdgcn_exp2f(SA1[r] - rm); }
#pragma unroll
        for (int i = 0; i < NDK; ++i) { if (NMAP == 2) A2_KRD1(i, 0, 1); else A2_KRD1(i, 1, 0); }
    }
#define A2_STEP(CUR0, CUR1, NXT0, NXT1, mpc, u, mpn, un, sl2, mp2, FIRSTN) do { \
        const LAS unsigned char* vb_ = vfb + ((u) % NVS) * VTB; float sacc = 0.f; \
        A2_INIT(NXT0, 0, un, mpn); A2_INIT(NXT1, 1, un, mpn); \
        _Pragma("unroll") for (int g = 0; g < NQ; ++g) { \
            if (g < NDK) A2_KRD1(NDK + g, (un) % NKS, mpn); \
            if (g == NQ - 3) A2_VRD(0); \
            if (g == NQ - 2) A2_VRD(1); \
            A2_SBAR(); \
            if (VAR != 1) { if (g < NDK) NXT0 = __builtin_amdgcn_mfma_f32_32x32x16_bf16(kf[g], qf[mpn][g % NDK], NXT0, 0, 0, 0); else NXT1 = __builtin_amdgcn_mfma_f32_32x32x16_bf16(kf[g], qf[mpn][g % NDK], NXT1, 0, 0, 0); } \
            else { A2_PIN(kf[g]); } \
            if (VAR != 3) { const int e0_ = (g * 32) / NQ, e1_ = ((g + 1) * 32) / NQ; \
                if (NQ == 4) sacc = fadd_s(sacc, fadd_s(fadd_s(fadd_s(A2_EL(CUR0, CUR1, e0_), A2_EL(CUR0, CUR1, e0_ + 1)), fadd_s(A2_EL(CUR0, CUR1, e0_ + 2), A2_EL(CUR0, CUR1, e0_ + 3))), \
                                                       fadd_s(fadd_s(A2_EL(CUR0, CUR1, e0_ + 4), A2_EL(CUR0, CUR1, e0_ + 5)), fadd_s(A2_EL(CUR0, CUR1, e0_ + 6), A2_EL(CUR0, CUR1, e0_ + 7))))); \
                else { _Pragma("unroll") for (int e = e0_; e < e1_; ++e) sacc += A2_EL(CUR0, CUR1, e); } } \
            A2_PIN(sacc); \
            if (VAR != 3) { _Pragma("unroll") for (int p = (g * 16) / NQ; p < ((g + 1) * 16) / NQ; ++p) pw[p >> 2][p & 3] = cvtpk(A2_EL(CUR0, CUR1, 2 * p), A2_EL(CUR0, CUR1, 2 * p + 1)); } \
            A2_PIN(pw[((g * 16) / NQ) >> 2]); A2_PIN(pw[(((g + 1) * 16) / NQ - 1) >> 2]); \
            A2_SBAR(); } \
        lsum[mpc] += sacc; \
        A2_MASK(NXT0, NXT1, un); \
        if (FIRSTN || chki != 0 || (un) < 4) { const float rm_ = rowmax32(NXT0, NXT1); \
          if (FIRSTN) { const float rc_ = max2f(rm_, -10000.f); mhat[mpn] = rc_; _Pragma("unroll") for (int r = 0; r < 16; ++r) { NXT0[r] -= rc_; NXT1[r] -= rc_; } } \
          else if ((un) < NT && __builtin_expect(__any(rm_ > THR), 0)) { const float dl = max2f(rm_, 0.f); mhat[mpn] += dl; \
            _Pragma("unroll") for (int r = 0; r < 16; ++r) { NXT0[r] -= dl; NXT1[r] -= dl; } \
            const float f_ = __builtin_amdgcn_exp2f(-dl); lsum[mpn] *= f_; fres[mpn] = f_; } } \
        A2_SBAR(); \
        _Pragma("unroll") for (int f = 0; f < 8; ++f) { \
            _Pragma("unroll") for (int i = (f * NDK) / 8; i < ((f + 1) * NDK) / 8; ++i) A2_KRD1(i, sl2, mp2); \
            if (f + 2 < 8) A2_VRD(f + 2); \
            A2_SBAR(); \
            { const bf16x8 vf_ = (bf16x8){vl[f][0], vl[f][1], vl[f][2], vl[f][3], vh[f][0], vh[f][1], vh[f][2], vh[f][3]}; \
              if (VAR != 1) O[mpc][f & 1] = __builtin_amdgcn_mfma_f32_32x32x16_bf16(vf_, __builtin_bit_cast(bf16x8, pw[f >> 1]), O[mpc][f & 1], 0, 0, 0); else { bf16x8 t_ = vf_; A2_PIN(t_); A2_PIN(pw[f >> 1]); } } \
            if (VAR != 3) { _Pragma("unroll") for (int e = 4 * f; e < 4 * f + 4; ++e) { if (e < 16) NXT0[e & 15] = __builtin_amdgcn_exp2f(NXT0[e & 15]); else NXT1[e & 15] = __builtin_amdgcn_exp2f(NXT1[e & 15]); } } \
            if (f < 4) A2_PIN(NXT0); else A2_PIN(NXT1); \
            A2_SBAR(); } \
        if (FIRSTN || chki != 0 || (un) < 4) _Pragma("unroll") for (int mp_ = 0; mp_ < NMAP; ++mp_) if (__any(fres[mp_] != 1.f)) { \
            _Pragma("unroll") for (int db = 0; db < 2; ++db) _Pragma("unroll") for (int r = 0; r < 16; ++r) O[mp_][db][r] *= fres[mp_]; fres[mp_] = 1.f; } \
    } while (0)
#define A2_ENDTILE(u) do { \
        if (ALIBI && (u) == 3) { float d_ = qn[0] - mhat[0]; if (NMAP == 2) d_ = max2f(d_, qn[NMAP - 1] - mhat[NMAP - 1]); \
            _Pragma("unroll") for (int o_ = 1; o_ < 64; o_ <<= 1) d_ = max2f(d_, __shfl_xor(d_, o_)); \
            if (lane == 0) flags[wid] = __float_as_uint(d_); } \
        if (VAR != 2) { asm volatile("s_waitcnt vmcnt(0)" ::: "memory"); __syncthreads(); } \
        if (ALIBI && (u) == 3) { const u32x4 f0 = *(const LAS u32x4*)(lds + OFF_FLAG), f1 = *(const LAS u32x4*)(lds + OFF_FLAG + 16); \
            const float D_ = max2f(max3f(__uint_as_float(f0.x), __uint_as_float(f0.y), __uint_as_float(f0.z)), max3f(__uint_as_float(f0.w), __uint_as_float(f1.x), __uint_as_float(f1.y))); \
            const float D2_ = max3f(D_, __uint_as_float(f1.z), __uint_as_float(f1.w)); \
            int n_ = (int)floorf((SKIP_THR + D2_) / (64.f * cb)) + 1; n_ = n_ < 4 ? 4 : n_; \
            nt_eff = __builtin_amdgcn_readfirstlane(n_ < NT ? n_ : NT); } \
    } while (0)
    int nt_eff = NT;
    if (NMAP == 2) {
        for (int u = 0; u < nt_eff; ++u) {
            if (u + 2 < NT) A2_DMAK(u + 2);
            if (u + 1 < NT) A2_DMAV(u + 1);
            A2_STEP(SA0, SA1, SB0, SB1, 0, u, NMAP - 1, u, (u + 1) % 3, 0, (u == 0));
            A2_STEP(SB0, SB1, SA0, SA1, NMAP - 1, u, 0, u + 1, (u + 1) % 3, NMAP - 1, false);
            A2_ENDTILE(u);
        }
    } else {
        for (int u = 0; u < NT; u += 2) {
            if (u + 4 < NT) { A2_DMAK(u + 4); A2_DMAK(u + 5); }
            if (u + 2 < NT) { A2_DMAV(u + 2); A2_DMAV(u + 3); }
            A2_STEP(SA0, SA1, SB0, SB1, 0, u, 0, u + 1, (u + 2) % NKS, 0, false);
            A2_STEP(SB0, SB1, SA0, SA1, 0, u + 1, 0, u + 2, (u + 3) % NKS, 0, false);
            A2_ENDTILE(u + 1);
        }
    }
#undef A2_DMAK
#undef A2_DMAV
#undef A2_EL
#undef A2_KRD1
#undef A2_VRD
#undef A2_INIT
#undef A2_MASK
#undef A2_STEP
#undef A2_ENDTILE
    float ltot[NMAP];
#pragma unroll
    for (int mp = 0; mp < NMAP; ++mp) ltot[mp] = xhalf_sum(lsum[mp]);
    epi(O, ltot, wid * 32 + r32, r32, hi);
    if (chk) return false;
    unsigned mxb = 0u;
#pragma unroll
    for (int mp = 0; mp < NMAP; ++mp) { const unsigned lb = __float_as_uint(ltot[mp]) & 0x7fffffffu; mxb = mxb > lb ? mxb : lb;
#pragma unroll
        for (int db = 0; db < 2; ++db)
#pragma unroll
            for (int r = 0; r < 16; ++r) { const unsigned ob = __float_as_uint(O[mp][db][r]) & 0x7fffffffu; mxb = mxb > ob ? mxb : ob; } }
    if (__any(mxb >= 0x7f800000u) && lane == 0) flags[8 + wid] = 1u;
    __syncthreads();
    const u32x4 g0 = *(const LAS u32x4*)(lds + OFF_FLAG + 32), g1 = *(const LAS u32x4*)(lds + OFF_FLAG + 48);
    return (g0.x | g0.y | g0.z | g0.w | g1.x | g1.y | g1.z | g1.w) != 0u;
}
}

struct Args { const void* in[30]; float* out; unsigned char* ws; int ph_lo, ph_hi; int reps, pad_; };
constexpr int N_PHASES = 13;
#ifndef MK_N_LAUNCHES
#define MK_N_LAUNCHES 1
#endif
#ifndef CONV_WG
#define CONV_WG 64
#endif
#ifndef PROBE_VAR
#define PROBE_VAR -1
#endif
#ifndef PROBE_PH
#define PROBE_PH 0
#endif
#ifndef PROBE_REP_MLA
#define PROBE_REP_MLA 1
#endif
#ifndef PROBE_REP_DIFF
#define PROBE_REP_DIFF 1
#endif

struct P0Item { const float* W; const float* gain; unsigned char* WT; int K, N, row_off, goff, mode, f8, k0, n0; float scale; };
__device__ __forceinline__ void p0_item_load(const P0Item& d, int lane, f32x4 (&v)[8], float (&g)[8]) {
    const int lr = lane >> 4, lc = 4 * (lane & 15); const bool cok = (d.n0 + lc) < d.N;
#pragma unroll
    for (int i = 0; i < 8; ++i) { const int k = d.k0 + 4 * i + lr; v[i] = cok ? *(const f32x4*)(d.W + (size_t)k * d.N + d.n0 + lc) : (f32x4){0.f, 0.f, 0.f, 0.f};
        g[i] = (d.gain && k >= d.goff) ? d.gain[k - d.goff] : 1.f; }
}
__device__ __forceinline__ void p0_item_finish(const P0Item& d, int lane, const f32x4 (&v)[8], const float (&g)[8], LAS float* scr) {
    const int lr = lane >> 4, lc = 4 * (lane & 15);
#pragma unroll
    for (int i = 0; i < 8; ++i) { const int kk = 4 * i + lr; const float gs = g[i] * d.scale;
        LAS float* p = scr + kk * 65 + lc; p[0] = v[i][0] * gs; p[1] = v[i][1] * gs; p[2] = v[i][2] * gs; p[3] = v[i][3] * gs; }
    LDS_WAIT(); asm volatile("" ::: "memory");
    const int c = lane & 3;
#pragma unroll
    for (int j = 0; j < 4; ++j) { const int n = (lane >> 2) + 16 * j; const LAS float* sp = scr + (8 * c) * 65 + n;
        const int col = d.n0 + n; int row = col;
        if (d.mode == 1) row = 2 * (col & ~15) + (col & 15);
        if (d.mode == 2) row = 2 * (col & ~15) + 16 + (col & 15);
        if (d.f8) { unsigned w0 = 0, w1 = 0;
            w0 = __builtin_amdgcn_cvt_pk_fp8_f32(sp[0 * 65], sp[1 * 65], w0, false); w0 = __builtin_amdgcn_cvt_pk_fp8_f32(sp[2 * 65], sp[3 * 65], w0, true);
            w1 = __builtin_amdgcn_cvt_pk_fp8_f32(sp[4 * 65], sp[5 * 65], w1, false); w1 = __builtin_amdgcn_cvt_pk_fp8_f32(sp[6 * 65], sp[7 * 65], w1, true);
            if (col < d.N) *(u32x2*)(d.WT + (size_t)(d.row_off + row) * d.K + d.k0 + 8 * c) = (u32x2){w0, w1}; }
        else { u32x4 o; o.x = cvtpk(sp[0 * 65], sp[1 * 65]); o.y = cvtpk(sp[2 * 65], sp[3 * 65]); o.z = cvtpk(sp[4 * 65], sp[5 * 65]); o.w = cvtpk(sp[6 * 65], sp[7 * 65]);
            if (col < d.N) *(u32x4*)(d.WT + ((size_t)(d.row_off + row) * d.K + d.k0 + 8 * c) * 2) = o; } }
    LDS_WAIT(); asm volatile("" ::: "memory");
}
template <int NR> __device__ __forceinline__ void rms_rows_load(const float* xrow, int lane, f32x4 (&v)[NR][4]) {
#pragma unroll
    for (int r = 0; r < NR; ++r)
#pragma unroll
        for (int j = 0; j < 4; ++j) v[r][j] = ((const f32x4*)(xrow + (size_t)r * DM) + lane)[64 * j];
}
template <int NR> __device__ __forceinline__ void rms_rows_finish(const f32x4 (&v)[NR][4], const float* gain, bf16* orow, int lane, float* inv_rs = nullptr) {
    float s[NR];
#pragma unroll
    for (int r = 0; r < NR; ++r) { s[r] = 0.f;
#pragma unroll
        for (int j = 0; j < 4; ++j) s[r] += pg8::sq4(v[r][j]); }
#pragma unroll
    for (int o = 1; o < 64; o <<= 1)
#pragma unroll
        for (int r = 0; r < NR; ++r) s[r] += __shfl_xor(s[r], o);
    const f32x4* gr = (const f32x4*)gain + lane;
    if (inv_rs && lane == 0) {
#pragma unroll
        for (int r = 0; r < NR; ++r) inv_rs[r] = 1.f / __builtin_amdgcn_rsqf(s[r] * (1.f / DM) + EPS); }
#pragma unroll
    for (int j = 0; j < 4; ++j) { const f32x4 g = gain ? gr[64 * j] : (f32x4){1.f, 1.f, 1.f, 1.f};
#pragma unroll
        for (int r = 0; r < NR; ++r) { const float rs = __builtin_amdgcn_rsqf(s[r] * (1.f / DM) + EPS); const f32x4 y = v[r][j] * rs * g; u32x2 w; w.x = cvtpk(y[0], y[1]); w.y = cvtpk(y[2], y[3]); ((u32x2*)(orow + (size_t)r * DM) + lane)[64 * j] = w; } }
}
__device__ __forceinline__ float pk_sq4(float a, float b, float c, float d) { return (a * a + b * b) + (c * c + d * d); }

struct EpiDiff {
    bf16* out; float lam; const float* gain;
    __device__ __forceinline__ void operator()(const f32x16 (&O)[2][2], const float (&l)[2], int qrow, int r32, int hi) const {
        const float i1 = 1.f / l[0], i2 = lam / l[1]; float o[2][16]; float ss = 0.f;
#pragma unroll
        for (int db = 0; db < 2; ++db)
#pragma unroll
            for (int r = 0; r < 16; ++r) { const float v = O[0][db][r] * i1 - O[1][db][r] * i2; o[db][r] = v; ss += v * v; }
        ss += __shfl_xor(ss, 32);
        const float rs = __builtin_amdgcn_rsqf(ss * (1.f / 64.f) + EPS) * (1.f - LAMBDA_INIT);
        bf16* rowp = out + (size_t)qrow * DM;
#pragma unroll
        for (int db = 0; db < 2; ++db)
#pragma unroll
            for (int rq = 0; rq < 4; ++rq) { const int d = 32 * db + 8 * rq + 4 * hi; const f32x4 g = *(const f32x4*)(gain + d);
                const f32x4 v = (f32x4){o[db][4 * rq] * g[0], o[db][4 * rq + 1] * g[1], o[db][4 * rq + 2] * g[2], o[db][4 * rq + 3] * g[3]} * rs; pg8::st4(rowp + d, v); }
    }
};
struct EpiMla {
    bf16* out; float* ssq;
    __device__ __forceinline__ void operator()(const f32x16 (&O)[1][2], const float (&l)[1], int qrow, int r32, int hi) const {
        const float il = 1.f / l[0]; float ss = 0.f; bf16* rowp = out + (size_t)qrow * DM;
#pragma unroll
        for (int db = 0; db < 2; ++db)
#pragma unroll
            for (int rq = 0; rq < 4; ++rq) { const int d = 32 * db + 8 * rq + 4 * hi;
                const f32x4 v = (f32x4){O[0][db][4 * rq], O[0][db][4 * rq + 1], O[0][db][4 * rq + 2], O[0][db][4 * rq + 3]} * il; ss += pg8::sq4(v); pg8::st4(rowp + d, v); }
        ss += __shfl_xor(ss, 32);
        if (hi == 0) ssq[(size_t)qrow * 8] = ss;
    }
};
struct EpiCross {
    unsigned char* out;
    __device__ __forceinline__ void operator()(const f32x16 (&O)[1][4], const float (&l)[1], int qrow, int r32, int hi) const {
        const float il = 8.f / l[0]; unsigned char* rowp = out + (size_t)qrow * 512;
#pragma unroll
        for (int db = 0; db < 4; ++db)
#pragma unroll
            for (int rq = 0; rq < 4; ++rq) { const int d = 32 * db + 8 * rq + 4 * hi; unsigned w = 0;
                w = __builtin_amdgcn_cvt_pk_fp8_f32(O[0][db][4 * rq] * il, O[0][db][4 * rq + 1] * il, w, false); w = __builtin_amdgcn_cvt_pk_fp8_f32(O[0][db][4 * rq + 2] * il, O[0][db][4 * rq + 3] * il, w, true);
                *(unsigned*)(rowp + d) = w; }
    }
};

__global__ void __launch_bounds__(NWAVES * 64, 2) mega_fwd(Args args) {
    extern __shared__ __attribute__((aligned(16))) unsigned char lds_raw[];
    LAS unsigned char* lds = (LAS unsigned char*)lds_raw;
    volatile LAS unsigned* MISC = (volatile LAS unsigned*)(lds + MISC_OFF);
    LAS int* TP = (LAS int*)(lds + TP_OFF);
    const int tid = threadIdx.x, lane = tid & 63, wave = __builtin_amdgcn_readfirstlane(tid >> 6);
    const int G = gridDim.x; const int bx = blockIdx.x; const int vcu = (G % 8 == 0) ? (bx % 8) * (G / 8) + bx / 8 : bx;
    typedef const void* cvp_t;
    __attribute__((address_space(4))) const unsigned char* kp = (__attribute__((address_space(4))) const unsigned char*)__builtin_amdgcn_kernarg_segment_ptr();
    asm volatile("" : "+s"(kp));
#define KARG(i) (*(const __attribute__((address_space(4))) cvp_t*)(kp + 8 * (i)))
#define ws ((unsigned char*)KARG(31))
#define ctl ((unsigned*)(ws + WS_CTL))
#define xin ((const float*)KARG(0))
#define mem ((const float*)KARG(1))
#define positions ((const int*)KARG(2))
#define norm_mix_g ((const float*)KARG(3))
#define w_in ((const float*)KARG(4))
#define lq1 ((const float*)KARG(5))
#define lk1 ((const float*)KARG(6))
#define lq2 ((const float*)KARG(7))
#define lk2 ((const float*)KARG(8))
#define diff_out_g ((const float*)KARG(9))
#define mla_q_norm_g ((const float*)KARG(10))
#define w_mla_uq ((const float*)KARG(11))
#define mla_kv_norm_g ((const float*)KARG(12))
#define w_mla_ukv ((const float*)KARG(13))
#define mla_out_g ((const float*)KARG(14))
#define w_out ((const float*)KARG(15))
#define norm_cross_g ((const float*)KARG(16))
#define norm_mem_g ((const float*)KARG(17))
#define w_mem_q ((const float*)KARG(18))
#define w_mem_kv ((const float*)KARG(19))
#define w_mem_o ((const float*)KARG(20))
#define norm_ffn_g ((const float*)KARG(21))
#define w_group_router ((const float*)KARG(22))
#define b_group_router ((const float*)KARG(23))
#define w_expert_router ((const float*)KARG(24))
#define b_expert_router ((const float*)KARG(25))
#define w_expert_gate ((const float*)KARG(26))
#define w_expert_up ((const float*)KARG(27))
#define w_expert_down ((const float*)KARG(28))
#define norm_final_g ((const float*)KARG(29))
#define W_IN ((bf16*)(ws + WS_WIN))
#define W_UQ ((bf16*)(ws + WS_WUQ))
#define W_UKV ((bf16*)(ws + WS_WUKV))
#define W_OUT ((bf16*)(ws + WS_WOUT))
#define W_MQ ((bf16*)(ws + WS_WMQ))
#define W_MKV ((bf16*)(ws + WS_WMKV))
#define W_MO ((bf16*)(ws + WS_WMO))
#define W_R ((bf16*)(ws + WS_WR))
#define W_GU ((bf16*)(ws + WS_WGU))
#define W_DN ((bf16*)(ws + WS_WDN))
#define RCOS ((float*)(ws + WS_ROPE))
#define SSQM ((float*)(ws + WS_SSQM))
#define SSQ1 ((float*)(ws + WS_SSQ1))
#define SSQ2 ((float*)(ws + WS_SSQ2))
#define SSQQ ((float*)(ws + WS_SSQQ))
#define SSQKV ((float*)(ws + WS_SSQKV))
#define KC ((bf16*)(ws + WS_KC))
#define VC ((bf16*)(ws + WS_VC))
#define MEMN ((bf16*)(ws + WS_MEMN))
#define WTS ((float*)(ws + WS_WT))
#define RS2 ((float*)(ws + WS_RS2))
#define MISCF ((float*)(ws + WS_MISC))
#define LIST ((int*)(ws + WS_LIST))
#define XN ((bf16*)(ws + WS_A0))
#define MIX ((bf16*)(ws + WS_MIX))
#define HB ((bf16*)(ws + WS_A0))
#define QD ((bf16*)(ws + WS_QD))
#define KD ((bf16*)(ws + WS_KD))
#define VD ((bf16*)(ws + WS_VD))
#define X1B ((bf16*)(ws + WS_X1B))
#define QC ((bf16*)(ws + WS_QC))
#define CQ ((bf16*)(ws + WS_CQ))
#define CKV ((bf16*)(ws + WS_CKV))
#define QM ((bf16*)(ws + WS_QM))
#define KM ((bf16*)(ws + WS_KM))
#define VM ((bf16*)(ws + WS_VM))
#define X2B ((bf16*)(ws + WS_X2B))
#define OC ((bf16*)(ws + WS_OC))
#define YB ((bf16*)(ws + WS_Y))
#define RSIN (RCOS + (size_t)T * 16)
#define CNT (ctl + CW_CNT)

    for (int u = tid; u < (LDS_BYTES - LDSCTL_OFF) / 4; u += NWAVES * 64) ((LAS unsigned*)(lds + LDSCTL_OFF))[u] = 0u;
    __syncthreads();
    XcdBarrier bar; bar.bar = ctl + CW_BAR; bar.x = 0; bar.st = nullptr;
    if (MK_N_LAUNCHES == 1) bar = xcd_barrier_post(ctl + CW_BAR, MISC);
    const int lo = *(const __attribute__((address_space(4))) int*)(kp + 256), hi_ph = *(const __attribute__((address_space(4))) int*)(kp + 260);
#ifndef PH_MASK
#define PH_MASK 0xFFFF
#endif
#define IN(k) (((PH_MASK >> (k)) & 1) && lo <= (k) && (k) < hi_ph)
#define SEAM(k) do { if (IN(k) && IN((k) + 1)) xcd_barrier(bar); } while (0)
    const int gw = vcu * NWAVES + wave, NGW = G * NWAVES;

    constexpr int I_IN = 32 * 31, I_UQ = 8 * 12, I_UKV = 4 * 16, I_OUT = 32 * 16, I_MQ = 32 * 8, I_MKV = 32 * 16, I_MO = 16 * 16, I_G = 32 * 4, I_D = 8 * 16;
    constexpr int C0 = NEXP * I_G, C1 = C0 + NEXP * I_G, C2 = C1 + NEXP * I_D, C3 = C2 + I_OUT, C4 = C3 + I_MQ, C5 = C4 + I_MKV, C6 = C5 + I_MO, C7 = C6 + I_UQ, C8 = C7 + I_UKV, C9 = C8 + I_IN;
    _Pragma("unroll") for (int rep_ = 0; rep_ < (((PROBE_PH >> 0) & 1) ? 2 : 1); ++rep_) if (IN(0)) {
        LAS float* scr = (LAS float*)(lds + wave * 16384);
#define P0_DECODE(idx, d) do { int r_ = (idx); int it_; \
            if (r_ < C0) { const int e = r_ / I_G; it_ = r_ % I_G; d = P0Item{w_expert_gate + (size_t)e * DM * EFF, norm_ffn_g, (unsigned char*)W_GU, DM, EFF, e * 512, 0, 1, 1, 0, 0, 32.f}; } \
            else if (r_ < C1) { r_ -= C0; const int e = r_ / I_G; it_ = r_ % I_G; d = P0Item{w_expert_up + (size_t)e * DM * EFF, norm_ffn_g, (unsigned char*)W_GU, DM, EFF, e * 512, 0, 2, 1, 0, 0, 32.f}; } \
            else if (r_ < C2) { r_ -= C1; const int e = r_ / I_D; it_ = r_ % I_D; d = P0Item{w_expert_down + (size_t)e * EFF * DM, nullptr, (unsigned char*)W_DN, EFF, DM, e * 1024, 0, 0, 1, 0, 0, 16.f}; } \
            else if (r_ < C3) { it_ = r_ - C2; d = P0Item{w_out, mla_out_g, (unsigned char*)W_OUT, DM, DM, 0, 512, 0, 0, 0, 0, 1.f}; } \
            else if (r_ < C4) { it_ = r_ - C3; d = P0Item{w_mem_q, norm_cross_g, (unsigned char*)W_MQ, DM, 512, 0, 0, 0, 0, 0, 0, 1.f}; } \
            else if (r_ < C5) { it_ = r_ - C4; d = P0Item{w_mem_kv, nullptr, (unsigned char*)W_MKV, DM, 1024, 0, 0, 0, 0, 0, 0, 1.f}; } \
            else if (r_ < C6) { it_ = r_ - C5; d = P0Item{w_mem_o, nullptr, (unsigned char*)W_MO, 512, 1024, 0, 0, 0, 1, 0, 0, 16.f}; } \
            else if (r_ < C7) { it_ = r_ - C6; d = P0Item{w_mla_uq, mla_q_norm_g, (unsigned char*)W_UQ, 256, 768, 0, 0, 0, 0, 0, 0, 1.f}; } \
            else if (r_ < C8) { it_ = r_ - C7; d = P0Item{w_mla_ukv, mla_kv_norm_g, (unsigned char*)W_UKV, 128, 1024, 0, 0, 0, 0, 0, 0, 1.f}; } \
            else { it_ = r_ - C8; d = P0Item{w_in, norm_mix_g, (unsigned char*)W_IN, DM, INW, 0, 0, 0, 0, 0, 0, 1.f}; } \
            { const int nblk_ = (d.N + 63) / 64; d.k0 = 32 * (it_ / nblk_); d.n0 = 64 * (it_ % nblk_); } } while (0)
        {
            P0Item dc, dn; f32x4 va[8], vb[8]; float ga[8], gb[8];
            int idx = C2 + gw;
            if (idx < C9) { P0_DECODE(idx, dc); p0_item_load(dc, lane, va, ga); }
            while (idx < C9) {
                const int nx = idx + NGW; const bool hn = nx < C9;
                if (hn) { P0_DECODE(nx, dn); p0_item_load(dn, lane, vb, gb); }
                p0_item_finish(dc, lane, va, ga, scr);
                if (hn) { dc = dn;
#pragma unroll
                    for (int i = 0; i < 8; ++i) { va[i] = vb[i]; ga[i] = gb[i]; } }
                idx = nx;
            }
        }
        {
            f32x4 xa[4][4], xb[4][4]; int m = gw * 4;
            if (m < T) rms_rows_load<4>(xin + (size_t)m * DM, lane, xa);
            while (m < T) {
                const int mn = m + NGW * 4; const bool hn = mn < T;
                if (hn) rms_rows_load<4>(xin + (size_t)mn * DM, lane, xb);
                rms_rows_finish<4>(xa, nullptr, XN + (size_t)m * DM, lane, (float*)(ws + WS_RS0) + m);
                if (hn) {
#pragma unroll
                    for (int r = 0; r < 4; ++r)
#pragma unroll
                        for (int j = 0; j < 4; ++j) xa[r][j] = xb[r][j]; }
                m = mn;
            }
        }
        for (int m = gw; m < NB * NMEM; m += NGW) { f32x4 xm[1][4]; rms_rows_load<1>(mem + (size_t)m * DM, lane, xm); rms_rows_finish<1>(xm, norm_mem_g, MEMN + (size_t)m * DM, lane); }
        for (int i = vcu * 512 + tid; i < T * 16; i += G * 512) {
            const int tk = i >> 4, fi = i & 15;
            const float invf = (float)exp2(-(double)fi * (13.287712379549449 / 16.0));
            const float ang = (float)positions[tk] * invf;
            const double xd = (double)ang; const double kq = rint(xd * 0.6366197723675814);
            double rr = fma(-kq, 1.5707963267948966, xd); rr = fma(-kq, 6.123233995736766e-17, rr);
            const double r2 = rr * rr;
            const double sn = rr * (1.0 + r2 * (-1.0 / 6 + r2 * (1.0 / 120 + r2 * (-1.0 / 5040 + r2 * (1.0 / 362880 + r2 * (-1.0 / 39916800))))));
            const double cs = 1.0 + r2 * (-0.5 + r2 * (1.0 / 24 + r2 * (-1.0 / 720 + r2 * (1.0 / 40320 + r2 * (-1.0 / 3628800 + r2 * (1.0 / 479001600))))));
            const int q = ((int)kq) & 3;
            const double c = (q == 0) ? cs : (q == 1) ? -sn : (q == 2) ? -cs : sn;
            const double s = (q == 0) ? sn : (q == 1) ? cs : (q == 2) ? -sn : -cs;
            RCOS[i] = (float)c; RSIN[i] = (float)s;
        }
        for (int i = vcu * 512 + tid; i < 36 * DM; i += G * 512) {
            const int n = i / DM, k = i % DM;
            const float w = (n < 32 ? w_expert_router[(size_t)k * 32 + n] : w_group_router[(size_t)k * 4 + (n - 32)]) * norm_ffn_g[k];
            const unsigned h = f2bf(w); const float res = w - __uint_as_float(h << 16);
            W_R[i] = (bf16)h; W_R[36 * DM + i] = (bf16)f2bf(res);
        }
        if (bx == 0 && wave == 0) {
            float a = (lane < 32) ? lq1[lane] * lk1[lane] : 0.f, b = (lane < 32) ? lq2[lane] * lk2[lane] : 0.f;
            a = wave_sum(a); b = wave_sum(b);
            if (lane == 0) MISCF[0] = expf(a) - expf(b) + LAMBDA_INIT;
        }
    }
    SEAM(0);
    _Pragma("unroll") for (int rep_ = 0; rep_ < (((PROBE_PH >> 1) & 1) ? 2 : 1); ++rep_) if (IN(1)) {
        { pg8::InProjOrder S{bx, (const char*)W_IN, DM};
          pg8::EpiInProj E{QD, KD, VD, CQ, CKV, KM, SSQQ, SSQKV, RCOS, RSIN, ctl + CW_KMAX};
          pg8::gemm_phase<pg8::EpiInProj, pg8::InProjOrder, true>(lds, (const char*)XN, DM, DM, DM, S, E); }
        asm volatile("s_waitcnt vmcnt(0)" ::: "memory"); __syncthreads();
        if (bx < 128) { pg8::RowUnits S{bx & 127, 3, (const char*)W_UQ, 256, 2}; pg8::EpiUpQ E{QM, SSQQ, RCOS, RSIN};
            pg8::gemm_phase<pg8::EpiUpQ, pg8::RowUnits, true>(lds, (const char*)CQ, 256, 256, 256, S, E); }
        else if (bx < 256) { pg8::RowUnits S{bx & 127, 4, (const char*)W_UKV, 128, 2}; pg8::EpiUpKV E{KM, VM, SSQKV};
            pg8::gemm_phase<pg8::EpiUpKV, pg8::RowUnits, true>(lds, (const char*)CKV, 128, 128, 128, S, E); }
    }
    if (IN(2) && bx == G - 1) {
        LAS int* hist = (LAS int*)lds; int* UTAB = (int*)(ws + WS_UTAB);
        for (int ty = 0; ty < 2; ++ty) {
            __syncthreads();
            for (int i = tid; i < 136; i += 512) hist[i] = 0;
            __syncthreads();
            int cost[2];
#pragma unroll
            for (int k = 0; k < 2; ++k) { const int id = tid + 512 * k, qb = id & 31, h = (id >> 5) & 7; int tiles = 4 * (qb + 1);
                if (ty == 0) { const int est = 5 + ((72 << h) + 63) / 64; tiles = tiles < est ? tiles : est; }
                cost[k] = tiles; atomicAdd((int*)&hist[128 - tiles], 1); }
            __syncthreads();
            if (tid == 0) { int acc = 0; for (int i = 0; i < 129; ++i) { const int c = hist[i]; hist[i] = acc; acc += c; } }
            __syncthreads();
#pragma unroll
            for (int k = 0; k < 2; ++k) { const int pos = atomicAdd((int*)&hist[128 - cost[k]], 1); UTAB[ty * 1024 + pos] = tid + 512 * k; }
        }
        __syncthreads();
    }
    SEAM(2);
    if (IN(3)) {
        const float lam = MISCF[0];
        { pg8::DenseOrder S; S.init(NB * NMEM, 1024, 16, bx, DM, W_MKV, DM); pg8::EpiMemKV E{KC, VC};
          if (bx < 16) pg8::gemm_phase<pg8::EpiMemKV, pg8::DenseOrder, true>(lds, (const char*)MEMN, DM, DM, DM, S, E); }
        if (bx >= 16 && bx < 16 + CONV_WG) {
            int tid_c = threadIdx.x; asm volatile("" : "+v"(tid_c));
            const int lane_c = tid_c & 63, wave_c = __builtin_amdgcn_readfirstlane(tid_c >> 6);
            LAS float* scr = (LAS float*)(lds + wave_c * 16384);
            P0Item dc, dn; f32x4 va[8], vb[8]; float ga[8], gb[8];
            int idx = (bx - 16) * NWAVES + wave_c;
            if (idx < C2) { P0_DECODE(idx, dc); p0_item_load(dc, lane_c, va, ga); }
            while (idx < C2) {
                const int nx = idx + CONV_WG * NWAVES; const bool hn = nx < C2;
                if (hn) { P0_DECODE(nx, dn); p0_item_load(dn, lane_c, vb, gb); }
                p0_item_finish(dc, lane_c, va, ga, scr);
                if (hn) { dc = dn;
#pragma unroll
                    for (int i = 0; i < 8; ++i) { va[i] = vb[i]; ga[i] = gb[i]; } }
                idx = nx;
            }
            __syncthreads();
        }
        const int* UTAB = (const int*)(ws + WS_UTAB);
        volatile LAS int* qslot = (volatile LAS int*)(lds + TP_OFF + 160);
#ifndef ATT_NO_DIFF
        {
            if (tid == 0) qslot[0] = (int)atomicAdd(ctl + CW_QHEAD, 1u);
            __syncthreads();
            bool chk = false; int nxt = 0;
            for (;;) {
                const int qi = qslot[0];
                __syncthreads();
                if (qi >= 1024) break;
                if (!chk && tid == 0) nxt = (int)atomicAdd(ctl + CW_QHEAD, 1u);
                const int id = UTAB[qi], qb = id & 31, bh = id >> 5, b = bh >> 3, h = bh & 7;
                const size_t rowb = (size_t)b * SEQ; const int q0 = qb * 256; const int NT = (q0 + 256) / 64;
                const float km0 = sqrtf(__uint_as_float(__hip_atomic_load(ctl + CW_KMAX + b * 16 + h * 2, __ATOMIC_RELAXED, __HIP_MEMORY_SCOPE_AGENT))) * 1.02f;
                const float km1 = sqrtf(__uint_as_float(__hip_atomic_load(ctl + CW_KMAX + b * 16 + h * 2 + 1, __ATOMIC_RELAXED, __HIP_MEMORY_SCOPE_AGENT))) * 1.02f;
                EpiDiff E{MIX + (rowb + q0) * DM + h * 64, lam, diff_out_g};
                const bool bad = __builtin_amdgcn_readfirstlane((int)att2::unit<32, 2, true, 512, 512, 512, EpiDiff>(lds, QD + (rowb + q0) * 512 + h * 64, KD + rowb * 512 + h * 64, VD + rowb * 512 + h * 64, NT, q0, LOG2E * __builtin_amdgcn_exp2f(-(float)(h + 1)), km0, km1, E, chk)) != 0;
                chk = bad;
                if (!bad && tid == 0) qslot[0] = nxt;
                __syncthreads();
            }
        }
#endif
#ifndef ATT_NO_MLA
        {
            if (tid == 0) qslot[0] = (int)atomicAdd(ctl + CW_QHEAD + 64, 1u);
            __syncthreads();
            bool chk = false; int nxt = 0;
            for (;;) {
                const int qi = qslot[0];
                __syncthreads();
                if (qi >= 1024) break;
                if (!chk && tid == 0) nxt = (int)atomicAdd(ctl + CW_QHEAD + 64, 1u);
                const int id = UTAB[1024 + qi], qb = id & 31, bh = id >> 5, b = bh >> 3, h = bh & 7;
                const size_t rowb = (size_t)b * SEQ; const int q0 = qb * 256; const int NT = (q0 + 256) / 64;
                EpiMla E{MIX + (rowb + q0) * DM + 512 + h * 64, SSQM + (rowb + q0) * 8 + h};
                const bool bad = __builtin_amdgcn_readfirstlane((int)att2::unit<96, 1, false, 768, 768, 512, EpiMla>(lds, QM + (rowb + q0) * 768 + h * 96, KM + rowb * 768 + h * 96, VM + rowb * 512 + h * 64, NT, q0, 0.f, 0.f, 0.f, E, chk)) != 0;
                chk = bad;
                if (!bad && tid == 0) qslot[0] = nxt;
                __syncthreads();
            }
        }
#endif
#if PROBE_VAR >= 0
        for (int L = vcu; L < 1024; L += G) {
            const int round = L >> 8, slot = L & 255, bh = slot >> 3, s = slot & 7, b = bh >> 3, h = bh & 7, i = round & 3;
            const int qb = (i == 0) ? s : (i == 1) ? 15 - s : (i == 2) ? 16 + s : 31 - s;
            const size_t rowb = (size_t)b * SEQ; const int q0 = qb * 256; const int NT = (q0 + 256) / 64;
            EpiMla E{(bf16*)(ws + 400 * MiB) + (rowb + q0) * DM + 512 + h * 64, (float*)(ws + 470 * MiB) + (rowb + q0) * 8 + h};
            att2::unit<96, 1, false, 768, 768, 512, EpiMla, PROBE_VAR>(lds, QM + (rowb + q0) * 768 + h * 96, KM + rowb * 768 + h * 96, VM + rowb * 512 + h * 64, NT, q0, 0.f, 0.f, 0.f, E);
        }
#endif
    }
    SEAM(3);
    _Pragma("unroll") for (int rep_ = 0; rep_ < (((PROBE_PH >> 5) & 1) ? 2 : 1); ++rep_) if (IN(5)) {
        pg8::DenseOrder S; S.init(T, DM, G, bx, DM, W_OUT, DM); pg8::EpiResid<false, 8> E{nullptr, XN, X1B, SSQ1, SSQM, nullptr, 1.f, (const float*)(ws + WS_RS0)};
        pg8::gemm_phase<pg8::EpiResid<false, 8>, pg8::DenseOrder, true>(lds, (const char*)MIX, DM, DM, DM, S, E);
    }
    SEAM(5);
    _Pragma("unroll") for (int rep_ = 0; rep_ < (((PROBE_PH >> 6) & 1) ? 2 : 1); ++rep_) if (IN(6)) {
#define P67_BODY(L) do { \
            const int pm = (L) >> 1, pn = (L) & 1; \
            { pg8::OneUnit S{pm, pn, (const char*)W_MQ, DM, 2}; pg8::EpiCrossQ E{QC, SSQ1}; \
              pg8::gemm_phase<pg8::EpiCrossQ, pg8::OneUnit, true>(lds, (const char*)X1B, DM, DM, DM, S, E); } \
            asm volatile("s_waitcnt vmcnt(0)" ::: "memory"); __syncthreads(); \
            const int b = pm >> 5; const size_t row0 = (size_t)pm * 256; \
_Pragma("unroll 1") \
            for (int hh = 0; hh < 2; ++hh) { const int h = pn * 2 + hh; \
                EpiCross E{(unsigned char*)OC + row0 * 512 + h * 128}; \
                att::attn_unit<128, 1, 128, false, false, 512, 512, 512, EpiCross>(lds, QC + row0 * 512 + h * 128, KC + (size_t)b * NMEM * 512 + h * 128, VC + (size_t)b * NMEM * 512 + h * 128, NMEM / 64, 0, 0.f, E); } \
        } while (0)
        if (vcu < 256) P67_BODY(vcu);
#undef P67_BODY
    }
    SEAM(7);
    _Pragma("unroll") for (int rep_ = 0; rep_ < (((PROBE_PH >> 8) & 1) ? 2 : 1); ++rep_) if (IN(8)) {
        pg8::DenseOrder S; S.init(T, DM, G, bx, 512, W_MO, 512, 1); pg8::EpiResid<false, 0, true> E{nullptr, X1B, X2B, SSQ2, nullptr, ws + WS_X2Q, 1.f / 128.f, nullptr};
        pg8::gemm_phase<pg8::EpiResid<false, 0, true>, pg8::DenseOrder, true>(lds, (const char*)OC, 512, 512, 512, S, E);
    }
    SEAM(8);
    if (IN(9)) {
        for (int i = tid; i < 2 * 36 * 128; i += 512) { const int rowi = i >> 7, ch = i & 127; *(LAS u32x4*)(lds + rowi * 2064 + ch * 16) = *(const u32x4*)(W_R + (size_t)rowi * DM + ch * 8); }
        __syncthreads();
        const int r32 = lane & 31, hi = lane >> 5;
        const int m1 = 32 + (r32 < 4 ? r32 : 3);
        LAS unsigned* lcnt = (LAS unsigned*)(lds + TP_OFF + 256); LAS unsigned* lbase = lcnt + 32;
        for (int tt0 = 0; tt0 < T / 32; tt0 += NGW) {
            const int tt = tt0 + wave * G + vcu; const bool act = tt < T / 32;
            if (tid < 32) lcnt[tid] = 0u;
            __syncthreads();
            int e1 = 0, e2 = 0; unsigned p1 = 0, p2 = 0; float w1 = 0.f, w2 = 0.f; const int tok = tt * 32 + r32;
            if (act) {
                const bf16* xrow = X2B + (size_t)tok * DM + hi * 8;
                f32x16 a0, a1;
#pragma unroll
                for (int r = 0; r < 16; ++r) { a0[r] = 0.f; a1[r] = 0.f; }
#pragma unroll 4
                for (int s = 0; s < 64; ++s) {
                    const bf16x8 xf = *(const bf16x8*)(xrow + s * 16);
                    const LAS unsigned char* wp = lds + s * 32 + hi * 16;
                    const bf16x8 w0h = *(const LAS bf16x8*)(wp + r32 * 2064), w0l = *(const LAS bf16x8*)(wp + (36 + r32) * 2064);
                    const bf16x8 w1h = *(const LAS bf16x8*)(wp + m1 * 2064), w1l = *(const LAS bf16x8*)(wp + (36 + m1) * 2064);
                    a0 = __builtin_amdgcn_mfma_f32_32x32x16_bf16(w0h, xf, a0, 0, 0, 0); a0 = __builtin_amdgcn_mfma_f32_32x32x16_bf16(w0l, xf, a0, 0, 0, 0);
                    a1 = __builtin_amdgcn_mfma_f32_32x32x16_bf16(w1h, xf, a1, 0, 0, 0); a1 = __builtin_amdgcn_mfma_f32_32x32x16_bf16(w1l, xf, a1, 0, 0, 0);
                }
                const f32x4* pp = (const f32x4*)(SSQ2 + (size_t)tok * 16); const f32x4 p = (pp[0] + pp[1]) + (pp[2] + pp[3]);
                const float rs = __builtin_amdgcn_rsqf(((p[0] + p[1]) + (p[2] + p[3])) * (1.f / 1024.f) + EPS);
                float gl[4];
#pragma unroll
                for (int g = 0; g < 4; ++g) { const float mine = a1[g]; const float other = __shfl_xor(mine, 32); gl[g] = (hi == 0 ? mine : other) * rs + b_group_router[g]; }
                int gs = 0; float gm = gl[0];
#pragma unroll
                for (int g = 1; g < 4; ++g) if (gl[g] > gm) { gm = gl[g]; gs = g; }
                float gden = 0.f;
#pragma unroll
                for (int g = 0; g < 4; ++g) gden += __expf(gl[g] - gm);
                const float ggate = 1.f / gden;
                float mine4[4];
#pragma unroll
                for (int j = 0; j < 4; ++j) { const float v = (gs == 0) ? a0[j] : (gs == 1) ? a0[4 + j] : (gs == 2) ? a0[8 + j] : a0[12 + j]; mine4[j] = v * rs + b_expert_router[8 * gs + 4 * hi + j]; }
                float v8[8];
#pragma unroll
                for (int j = 0; j < 4; ++j) { const float o = __shfl_xor(mine4[j], 32); v8[j] = hi == 0 ? mine4[j] : o; v8[4 + j] = hi == 0 ? o : mine4[j]; }
                int i1 = 0; float b1 = v8[0];
#pragma unroll
                for (int j = 1; j < 8; ++j) if (v8[j] > b1) { b1 = v8[j]; i1 = j; }
                int i2 = -1; float b2 = -INFINITY;
#pragma unroll
                for (int j = 0; j < 8; ++j) if (j != i1 && v8[j] > b2) { b2 = v8[j]; i2 = j; }
                const float dd = __expf(b2 - b1); w1 = ggate / (1.f + dd); w2 = w1 * dd;
                e1 = 8 * gs + i1; e2 = 8 * gs + i2;
                if (hi == 0) { RS2[tok] = rs; p1 = atomicAdd((unsigned*)(lds_raw + TP_OFF + 256) + e1, 1u); p2 = atomicAdd((unsigned*)(lds_raw + TP_OFF + 256) + e2, 1u); }
            }
            __syncthreads();
            if (tid < 32) { const unsigned c = lcnt[tid]; lbase[tid] = c ? atomicAdd(CNT + 64 * tid, c) : 0u; }
            __syncthreads();
            if (act && hi == 0) {
                LIST[(size_t)e1 * T + lbase[e1] + p1] = 2 * tok; WTS[2 * tok] = w1; ((int*)(ws + WS_POS))[2 * tok] = (e1 << 16) | (int)(lbase[e1] + p1);
                LIST[(size_t)e2 * T + lbase[e2] + p2] = 2 * tok + 1; WTS[2 * tok + 1] = w2; ((int*)(ws + WS_POS))[2 * tok + 1] = (e2 << 16) | (int)(lbase[e2] + p2);
            }
            __syncthreads();
        }
    }
    SEAM(9);
    if (IN(10) || IN(11) || IN(12)) {
        if (tid == 0) { int acc = 0; for (int e = 0; e < NEXP; ++e) { TP[e] = acc; acc += (int)((__hip_atomic_load(CNT + 64 * e, __ATOMIC_RELAXED, __HIP_MEMORY_SCOPE_AGENT) + 255u) >> 8); } TP[NEXP] = acc; }
        __syncthreads();
    }
    _Pragma("unroll") for (int rep_ = 0; rep_ < (((PROBE_PH >> 10) & 1) ? 2 : 1); ++rep_) if (IN(10)) {
        pg8::MoeOrder<true> S{G, vcu, 2, DM, (const char*)W_GU, DM, (size_t)512 * DM, TP, CNT, LIST, 1};
        pg8::EpiMoeUp E{HB, LIST, RS2, TP};
        pg8::gemm_phase<pg8::EpiMoeUp, pg8::MoeOrder<true>, true>(lds, (const char*)(ws + WS_X2Q), DM, DM, DM, S, E);
    }
    SEAM(10);
    _Pragma("unroll") for (int rep_ = 0; rep_ < (((PROBE_PH >> 11) & 1) ? 2 : 1); ++rep_) if (IN(11)) {
        pg8::MoeOrder<false> S{G, vcu, 4, EFF, (const char*)W_DN, EFF, (size_t)1024 * EFF, TP, CNT, LIST, 1};
        pg8::EpiMoeDown E{YB};
        pg8::gemm_phase<pg8::EpiMoeDown, pg8::MoeOrder<false>, true>(lds, (const char*)HB, EFF, EFF, EFF, S, E);
    }
    SEAM(11);
    _Pragma("unroll") for (int rep_ = 0; rep_ < (((PROBE_PH >> 12) & 1) ? 2 : 1); ++rep_) if (IN(12)) {
        const f32x4 g00 = *(const f32x4*)(norm_final_g + lane * 8), g01 = *(const f32x4*)(norm_final_g + lane * 8 + 4), g10 = *(const f32x4*)(norm_final_g + (lane + 64) * 8), g11 = *(const f32x4*)(norm_final_g + (lane + 64) * 8 + 4);
        for (int m0 = gw * 4; m0 < T; m0 += NGW * 4) {
            u32x4 a[4][2]; u32x2 b[4][2], c[4][2]; float wa[4], wb[4];
#pragma unroll
            for (int r = 0; r < 4; ++r) { const int m = m0 + r;
                const int pa = ((const int*)(ws + WS_POS))[2 * m], pb = ((const int*)(ws + WS_POS))[2 * m + 1];
                const size_t sa = (size_t)TP[pa >> 16] * 256 + (pa & 0xffff), sb = (size_t)TP[pb >> 16] * 256 + (pb & 0xffff);
                wa[r] = WTS[2 * m]; wb[r] = WTS[2 * m + 1];
                const u32x4* xp = (const u32x4*)(X2B + (size_t)m * DM); const u32x2* y0 = (const u32x2*)((const unsigned char*)YB + sa * DM); const u32x2* y1 = (const u32x2*)((const unsigned char*)YB + sb * DM);
#pragma unroll
                for (int j = 0; j < 2; ++j) { a[r][j] = xp[lane + 64 * j]; b[r][j] = y0[lane + 64 * j]; c[r][j] = y1[lane + 64 * j]; } }
#pragma unroll
            for (int r = 0; r < 4; ++r) { const int m = m0 + r; float v[2][8]; float s = 0.f;
#pragma unroll
                for (int j = 0; j < 2; ++j)
#pragma unroll
                    for (int q2 = 0; q2 < 2; ++q2) { const f32x2 yb0 = __builtin_amdgcn_cvt_pk_f32_fp8(b[r][j][q2], false), yb1 = __builtin_amdgcn_cvt_pk_f32_fp8(b[r][j][q2], true), yc0 = __builtin_amdgcn_cvt_pk_f32_fp8(c[r][j][q2], false), yc1 = __builtin_amdgcn_cvt_pk_f32_fp8(c[r][j][q2], true);
                        const unsigned xa = a[r][j][2 * q2], xb = a[r][j][2 * q2 + 1];
                        v[j][4 * q2] = bf_lo(xa) + wa[r] * yb0[0] + wb[r] * yc0[0]; v[j][4 * q2 + 1] = bf_hi(xa) + wa[r] * yb0[1] + wb[r] * yc0[1];
                        v[j][4 * q2 + 2] = bf_lo(xb) + wa[r] * yb1[0] + wb[r] * yc1[0]; v[j][4 * q2 + 3] = bf_hi(xb) + wa[r] * yb1[1] + wb[r] * yc1[1];
                        s += (v[j][4 * q2] * v[j][4 * q2] + v[j][4 * q2 + 1] * v[j][4 * q2 + 1]) + (v[j][4 * q2 + 2] * v[j][4 * q2 + 2] + v[j][4 * q2 + 3] * v[j][4 * q2 + 3]); }
                const float rs = __builtin_amdgcn_rsqf(wave_sum(s) * (1.f / DM) + EPS);
                float* orow = (float*)KARG(30) + (size_t)m * DM;
                *(f32x4*)(orow + lane * 8) = (f32x4){v[0][0], v[0][1], v[0][2], v[0][3]} * rs * g00; *(f32x4*)(orow + lane * 8 + 4) = (f32x4){v[0][4], v[0][5], v[0][6], v[0][7]} * rs * g01;
                *(f32x4*)(orow + (lane + 64) * 8) = (f32x4){v[1][0], v[1][1], v[1][2], v[1][3]} * rs * g10; *(f32x4*)(orow + (lane + 64) * 8 + 4) = (f32x4){v[1][4], v[1][5], v[1][6], v[1][7]} * rs * g11; }
        }
    }
#undef P0_DECODE
#undef IN
#undef SEAM
#undef KARG
#undef ws
#undef ctl
#undef CNT
#undef W_IN
#undef W_UQ
#undef W_UKV
#undef W_OUT
#undef W_MQ
#undef W_MKV
#undef W_MO
#undef W_R
#undef W_GU
#undef W_DN
#undef RCOS
#undef SSQM
#undef SSQ1
#undef SSQ2
#undef SSQQ
#undef SSQKV
#undef KC
#undef VC
#undef MEMN
#undef WTS
#undef RS2
#undef MISCF
#undef LIST
#undef XN
#undef MIX
#undef HB
#undef QD
#undef KD
#undef VD
#undef X1B
#undef QC
#undef CQ
#undef CKV
#undef QM
#undef KM
#undef VM
#undef X2B
#undef OC
#undef YB
#undef RSIN
#undef xin
#undef mem
#undef positions
#undef norm_mix_g
#undef w_in
#undef lq1
#undef lk1
#undef lq2
#undef lk2
#undef diff_out_g
#undef mla_q_norm_g
#undef w_mla_uq
#undef mla_kv_norm_g
#undef w_mla_ukv
#undef mla_out_g
#undef w_out
#undef norm_cross_g
#undef norm_mem_g
#undef w_mem_q
#undef w_mem_kv
#undef w_mem_o
#undef norm_ffn_g
#undef w_group_router
#undef b_group_router
#undef w_expert_router
#undef b_expert_router
#undef w_expert_gate
#undef w_expert_up
#undef w_expert_down
#undef norm_final_g
}

extern "C" void kernel_launch(void* const* d_in, const int* in_sizes, int n_in, void* d_out, int out_size, void* d_ws, size_t ws_size, hipStream_t stream) {
    static int grid = 0;
    if (grid == 0) {
        if (n_in != 30 || out_size != T * DM || ws_size < WS_END) { fprintf(stderr, "kernel_launch: unexpected shapes (n_in %d, out %d, ws %zu)\n", n_in, out_size, ws_size); grid = -1; return; }
        int dev = 0, cus = 0, per_cu = 0;
        if (hipGetDevice(&dev) != hipSuccess || hipDeviceGetAttribute(&cus, hipDeviceAttributeMultiprocessorCount, dev) != hipSuccess) { grid = -1; return; }
        if (hipFuncSetAttribute((const void*)mega_fwd, hipFuncAttributeMaxDynamicSharedMemorySize, LDS_BYTES) != hipSuccess) { fprintf(stderr, "kernel_launch: hipFuncSetAttribute failed\n"); grid = -1; return; }
        if (hipOccupancyMaxActiveBlocksPerMultiprocessor(&per_cu, (const void*)mega_fwd, NWAVES * 64, LDS_BYTES) != hipSuccess || per_cu < 1) { fprintf(stderr, "kernel_launch: occupancy query reports %d\n", per_cu); }
        (void)hipGetLastError();
        if (cus < 256) { fprintf(stderr, "kernel_launch: built for a 256-CU MI355X (got %d CUs)\n", cus); grid = -1; return; }
        grid = cus;
    }
    if (grid < 0) return;
    if (hipMemsetAsync((char*)d_ws + WS_CTL, 0, CTL_ZERO_BYTES, stream) != hipSuccess) return;
    Args a{};
    for (int i = 0; i < 30; ++i) a.in[i] = d_in[i];
    a.out = (float*)d_out; a.ws = (unsigned char*)d_ws; a.reps = PROBE_PH; a.pad_ = 0;
#if MK_N_LAUNCHES == 1
    a.ph_lo = 0; a.ph_hi = N_PHASES;
    hipLaunchKernelGGL(mega_fwd, dim3(grid), dim3(NWAVES * 64), LDS_BYTES, stream, a);
#else
    for (int p = 0; p < N_PHASES; ++p) { a.ph_lo = p; a.ph_hi = p + 1; hipLaunchKernelGGL(mega_fwd, dim3(grid), dim3(NWAVES * 64), LDS_BYTES, stream, a); }
#endif
}
```

```cpp
#include <hip/hip_runtime.h>
#include <cstdio>
#include <cstdint>

#define LAS __attribute__((address_space(3)))
#define GAS __attribute__((address_space(1)))
typedef unsigned short bf16;
typedef short bf16x8 __attribute__((ext_vector_type(8)));
typedef short s16x4 __attribute__((ext_vector_type(4)));
typedef float f32x4 __attribute__((ext_vector_type(4)));
typedef float f32x2 __attribute__((ext_vector_type(2)));
typedef float f32x16 __attribute__((ext_vector_type(16)));
typedef unsigned u32x4 __attribute__((ext_vector_type(4)));
typedef unsigned u32x2 __attribute__((ext_vector_type(2)));
typedef __bf16 bf16x2_t __attribute__((ext_vector_type(2)));

constexpr int NB = 4, SEQ = 8192, DM = 1024, T = NB * SEQ;
constexpr int NMEM = 256;
constexpr int INW = 1952, INWP = 2048;
constexpr int NEXP = 32, EFF = 256;
constexpr float EPS = 1e-6f;
constexpr float LOG2E = 1.4426950408889634f;
constexpr float QS_D = 0.17677669529663687f * LOG2E;
constexpr float QS_M = 0.10206207261596577f * LOG2E;
constexpr float QS_C = 0.08838834764831845f * LOG2E;
constexpr float LAMBDA_INIT = 0.2f;

constexpr size_t MiB = 1u << 20;
constexpr size_t WS_CTL = 0, CTL_ZERO_BYTES = 1 * MiB;
constexpr size_t WS_WIN = 1 * MiB;
constexpr size_t WS_WUQ = 5 * MiB;
constexpr size_t WS_WUKV = 5 * MiB + 512 * 1024;
constexpr size_t WS_WOUT = 6 * MiB;
constexpr size_t WS_WMQ = 8 * MiB;
constexpr size_t WS_WMKV = 9 * MiB;
constexpr size_t WS_WMO = 11 * MiB;
constexpr size_t WS_WR = 12 * MiB;
constexpr size_t WS_WGU = 13 * MiB;
constexpr size_t WS_WDN = 45 * MiB;
constexpr size_t WS_ROPE = 61 * MiB;
constexpr size_t WS_SSQM = 65 * MiB;
constexpr size_t WS_SSQ1 = 66 * MiB;
constexpr size_t WS_SSQ2 = 68 * MiB;
constexpr size_t WS_SSQQ = 70 * MiB;
constexpr size_t WS_SSQKV = 70 * MiB + 512 * 1024;
constexpr size_t WS_KC = 71 * MiB;
constexpr size_t WS_VC = 72 * MiB;
constexpr size_t WS_MEMN = 73 * MiB;
constexpr size_t WS_WT = 75 * MiB;
constexpr size_t WS_RS2 = 75 * MiB + 512 * 1024;
constexpr size_t WS_MISC = 76 * MiB;
constexpr size_t WS_UTAB = 76 * MiB + 4096;
constexpr size_t WS_POS = 76 * MiB + 65536;
constexpr size_t WS_LIST = 77 * MiB;
constexpr size_t WS_A0 = 84 * MiB;
constexpr size_t WS_QD = 148 * MiB, WS_KD = 180 * MiB, WS_VD = 212 * MiB;
constexpr size_t WS_X1B = 148 * MiB;
constexpr size_t WS_QC = 212 * MiB;
constexpr size_t WS_X2Q = 212 * MiB;
constexpr size_t WS_CQ = 244 * MiB;
constexpr size_t WS_CKV = 260 * MiB;
constexpr size_t WS_QM = 268 * MiB;
constexpr size_t WS_KM = 316 * MiB;
constexpr size_t WS_VM = 364 * MiB;
constexpr size_t WS_X2B = 268 * MiB;
constexpr size_t WS_OC = 332 * MiB;
constexpr size_t WS_X1Q = 364 * MiB;
constexpr size_t WS_Y = 120 * MiB;
constexpr size_t WS_MIX = 396 * MiB;
constexpr size_t WS_RS0 = 76 * MiB + 327680;
constexpr size_t WS_REDO = 460 * MiB;
constexpr size_t WS_RSL = 462 * MiB;
constexpr size_t WS_END = 466 * MiB;
constexpr int CW_BAR = 4096;
constexpr int CW_KMAX = 8192;
constexpr int CW_QHEAD = 8448;
constexpr int CW_CNT = 16384;

constexpr int RING_BYTES = 131072;
constexpr int ROUTER_LDS = 2 * 36 * 2064;
constexpr int LDSCTL_OFF = 149504, MISC_OFF = LDSCTL_OFF + 64;
constexpr int TP_OFF = LDSCTL_OFF + 256;
constexpr int LDS_BYTES = 150528;
constexpr int NWAVES = 8;

__device__ __forceinline__ unsigned cvtpk(float lo, float hi) { f32x2 v = {lo, hi}; bf16x2_t b = __builtin_convertvector(v, bf16x2_t); return __builtin_bit_cast(unsigned, b); }
__device__ __forceinline__ float bf_lo(unsigned u) { return __uint_as_float(u << 16); }
__device__ __forceinline__ float bf_hi(unsigned u) { return __uint_as_float(u & 0xffff0000u); }
__device__ __forceinline__ unsigned f2bf(float f) { return cvtpk(f, 0.f) & 0xffffu; }
__device__ __forceinline__ float wave_sum(float v) {
#pragma unroll
    for (int o = 1; o < 64; o <<= 1) v += __shfl_xor(v, o);
    return v;
}
#define LDS_WAIT() asm volatile("s_waitcnt lgkmcnt(0)" ::: "memory")
#define VM_WAIT() asm volatile("s_waitcnt vmcnt(0)" ::: "memory")

#define XB_TMO      128
#define XB_XCNT(j)  (256  + 64 * (j))
#define XB_XSUB(j)  (1280 + 64 * (j))
#define XB_XGEN(j)  (2304 + 64 * (j))
#define XB_TOP      3328
#define XB_TOPGEN   3392
#define XCD_BAR_WORDS 3456
#define XB_SPIN_CAP (1u << 18)
__device__ __forceinline__ unsigned xb_ld(unsigned* p)              { return __hip_atomic_load(p, __ATOMIC_RELAXED, __HIP_MEMORY_SCOPE_AGENT); }
__device__ __forceinline__ unsigned xb_add(unsigned* p, unsigned v) { return __hip_atomic_fetch_add(p, v, __ATOMIC_RELAXED, __HIP_MEMORY_SCOPE_AGENT); }
__device__ __forceinline__ unsigned xb_xcc_id() { return (unsigned)__builtin_amdgcn_s_getreg((3 << 11) | 20) & 0xFu; }
#define XB_SPIN(cond, bar) do { unsigned _sp = 0; while (cond) { __builtin_amdgcn_s_sleep(1); \
    if ((++_sp & 255u) == 0u) { if (xb_ld(&(bar)[XB_TMO])) break; if (_sp > XB_SPIN_CAP) { atomicAdd(&(bar)[XB_TMO], 1u); break; } } } } while (0)
struct XcdBarrier { unsigned* bar; unsigned x; volatile LAS unsigned* st; };
__device__ __forceinline__ XcdBarrier xcd_barrier_post(unsigned* bar, volatile LAS unsigned* st) {
    XcdBarrier b; b.bar = bar; b.x = xb_xcc_id(); b.st = st;
    if (threadIdx.x == 0) (void)xb_add(&bar[XB_XCNT(b.x)], 1u);
    return b;
}
__device__ __forceinline__ void xcd_barrier_complete(unsigned* bar, unsigned x, unsigned& nloc, unsigned& nx) {
    const unsigned G = gridDim.x * gridDim.y * gridDim.z;
    unsigned sum, cnt, mine, sp = 0u;
    for (;;) {
        sum = 0u; cnt = 0u; mine = 0u;
#pragma unroll
        for (unsigned j = 0; j < 16; ++j) { const unsigned c = xb_ld(&bar[XB_XCNT(j)]); sum += c; cnt += (c > 0u) ? 1u : 0u; mine = (j == x) ? c : mine; }
        if (sum == G) break;
        __builtin_amdgcn_s_sleep(1);
        if ((++sp & 255u) == 0u) { if (xb_ld(&bar[XB_TMO])) break; if (sp > XB_SPIN_CAP) { atomicAdd(&bar[XB_TMO], 1u); break; } }
    }
    nloc = mine > 0u ? mine : 1u; nx = cnt > 0u ? cnt : 1u;
}
__device__ __forceinline__ void xcd_barrier(const XcdBarrier& b) {
    asm volatile("s_waitcnt vmcnt(0)" ::: "memory");
    __syncthreads();
    if (threadIdx.x == 0) {
        unsigned* bar = b.bar;
        __builtin_amdgcn_s_waitcnt(0);
        unsigned nloc = b.st[0], nx = b.st[1];
        if (nloc == 0u) { xcd_barrier_complete(bar, b.x, nloc, nx); b.st[0] = nloc; b.st[1] = nx; }
        const unsigned old = xb_add(&bar[XB_XSUB(b.x)], 1u);
        const unsigned gen = old / nloc;
        if (old + 1u == (gen + 1u) * nloc) {
            __builtin_amdgcn_fence(__ATOMIC_RELEASE, "agent");
            asm volatile("s_waitcnt vmcnt(0)" ::: "memory");
            const unsigned og = xb_add(&bar[XB_TOP], 1u);
            const unsigned tg = og / nx;
            if (og + 1u == (tg + 1u) * nx) xb_add(&bar[XB_TOPGEN], 1u);
            else XB_SPIN(xb_ld(&bar[XB_TOPGEN]) == tg, bar);
            __builtin_amdgcn_fence(__ATOMIC_ACQUIRE, "agent");
            xb_add(&bar[XB_XGEN(b.x)], 1u);
            asm volatile("s_waitcnt vmcnt(0)" ::: "memory");
        } else {
            XB_SPIN(xb_ld(&bar[XB_XGEN(b.x)]) == gen, bar);
            __builtin_amdgcn_fence(__ATOMIC_ACQUIRE, "agent");
            asm volatile("s_waitcnt vmcnt(0)" ::: "memory");
        }
    }
    __syncthreads();
}

namespace pg8 {
constexpr int BM = 256, BK = 64, HALF = 128, HTB = HALF * BK * 2, STAGE_BYTES = 8 * HTB, NXCD = 8, WGM = 8;
__device__ __forceinline__ int lds_byte(int r, int c) { const int st = (r >> 4) * 2 + (c >> 5), rr = r & 15, cc = c & 31, ob = rr * 64 + cc * 2; return st * 1024 + (ob ^ (((ob >> 9) & 1) << 5)); }
__device__ __forceinline__ int perm32(int rho) { const int n = rho >> 4, i = rho & 15; return 8 * (i >> 2) + 4 * n + (i & 3); }
__device__ __forceinline__ void stage_rc(int b, int& R, int& C) { const int st = b / 1024, sb = b % 1024, swz = sb ^ (((sb >> 9) & 1) << 5); R = (st >> 1) * 16 + swz / 64; C = (st & 1) * 32 + (swz % 64) / 2; }

struct Unit { int pm, pn, e, cnt; };

struct DenseOrder {
    static constexpr bool GATHER = false;
    int nM, nN, nwg, G, c, lda; const char* B; int ldb; int eb;
    __device__ void init(int M, int N, int G_, int c_, int lda_, const void* B_, int ldb_, int eb_ = 2) { nM = M / BM; nN = N / BM; nwg = nM * nN; G = G_; c = c_; lda = lda_; B = (const char*)B_; ldb = ldb_; eb = eb_; }
    __device__ __forceinline__ bool next(int i, Unit& u) const {
        const long L = (long)i * G + c; if (L >= nwg) return false;
        int wgid = (int)L; { const int q = nwg / NXCD, r = nwg % NXCD, xcd = wgid % NXCD, off = wgid / NXCD; wgid = (xcd < r ? xcd * (q + 1) : r * (q + 1) + (xcd - r) * q) + off; }
        const int nig = WGM * nN, gid = wgid / nig, fm = gid * WGM, gsz = (nM - fm) < WGM ? (nM - fm) : WGM;
        u.pm = fm + ((wgid % nig) % gsz); u.pn = (wgid % nig) / gsz; u.e = 0; u.cnt = 0; return true;
    }
    __device__ __forceinline__ void a_offs(const Unit&, const int (&)[2], const int (&)[2], unsigned (&)[2][2]) const {}
    __device__ __forceinline__ size_t a_rowtile(const Unit& u) const { return (size_t)u.pm; }
    __device__ __forceinline__ const char* b_ptr(const Unit& u) const { return B + (size_t)u.pn * BM * ldb * eb; }
};
struct OneUnit {
    static constexpr bool GATHER = false;
    int pm, pn; const char* B; int ldb; int eb;
    __device__ __forceinline__ bool next(int i, Unit& u) const { int i0 = i; asm volatile("" : "+s"(i0)); if (i0 != 0) return false; u.pm = pm; u.pn = pn; u.e = 0; u.cnt = 0; return true; }
    __device__ __forceinline__ void a_offs(const Unit&, const int (&)[2], const int (&)[2], unsigned (&)[2][2]) const {}
    __device__ __forceinline__ size_t a_rowtile(const Unit& u) const { return (size_t)u.pm; }
    __device__ __forceinline__ const char* b_ptr(const Unit& u) const { return B + (size_t)u.pn * BM * ldb * eb; }
};
struct RowUnits {
    static constexpr bool GATHER = false;
    int pm, n; const char* B; int ldb; int eb;
    __device__ __forceinline__ bool next(int i, Unit& u) const { int i0 = i; asm volatile("" : "+s"(i0)); if (i0 >= n) return false; int p0 = pm; asm volatile("" : "+s"(p0)); u.pm = p0; u.pn = i0; u.e = 0; u.cnt = 0; return true; }
    __device__ __forceinline__ void a_offs(const Unit&, const int (&)[2], const int (&)[2], unsigned (&)[2][2]) const {}
    __device__ __forceinline__ size_t a_rowtile(const Unit& u) const { return (size_t)u.pm; }
    __device__ __forceinline__ const char* b_ptr(const Unit& u) const { return B + (size_t)u.pn * BM * ldb * eb; }
};
struct InProjOrder {
    static constexpr bool GATHER = false;
    int c; const char* B; int ldb;
    __device__ __forceinline__ bool next(int i, Unit& u) const { int i0 = i; asm volatile("" : "+s"(i0)); if (i0 >= 4 || c >= 256) return false;
        const int p = c >> 7, off = (c >> 5) & 3; const int k = (i0 == 3) ? 3 : ((off % 3) + i0) % 3; u.pm = c & 127; u.pn = p + 2 * k; u.e = 0; u.cnt = 0; return true; }
    __device__ __forceinline__ void a_offs(const Unit&, const int (&)[2], const int (&)[2], unsigned (&)[2][2]) const {}
    __device__ __forceinline__ size_t a_rowtile(const Unit& u) const { return (size_t)u.pm; }
    __device__ __forceinline__ const char* b_ptr(const Unit& u) const { return B + (size_t)u.pn * BM * ldb * 2; }
};
template <bool GATHER_> struct MoeOrder {
    static constexpr bool GATHER = GATHER_;
    int G, c, NPN, lda; const char* B; int ldb; size_t bstride; const LAS int* TP; const unsigned* cntw; const int* list; int eb;
    __device__ __forceinline__ bool next(int i, Unit& u) const {
        const int ntile = TP[NEXP]; const long L = (long)i * G + c; if (L >= (long)ntile * NPN) return false;
        const int tile = (int)(L / NPN); u.pn = (int)(L % NPN); u.pm = tile;
        const int ln_ = (int)__builtin_amdgcn_mbcnt_hi(~0u, __builtin_amdgcn_mbcnt_lo(~0u, 0u));
        const int tp_ = (ln_ < NEXP) ? TP[ln_] : 0x7fffffff;
        const int e = (int)__popcll(__ballot(tp_ <= tile)) - 1;
        u.e = __builtin_amdgcn_readfirstlane(e);
        u.cnt = (int)__builtin_amdgcn_readfirstlane(TP[128 + u.e]);
        return true;
    }
    __device__ __forceinline__ void a_offs(const Unit& u, const int (&RA)[2], const int (&CA)[2], unsigned (&off)[2][2]) const {
        if constexpr (!GATHER) return;
        const int j = u.pm - TP[u.e];
#pragma unroll
        for (int h = 0; h < 2; ++h)
#pragma unroll
            for (int i = 0; i < 2; ++i) {
                const int idx = j * BM + h * HALF + RA[i]; const int a = (idx < u.cnt) ? list[(size_t)u.e * T + idx] : 0;
                off[h][i] = (unsigned)((a >> 1) * lda * eb + CA[i] * 2);
            }
    }
    __device__ __forceinline__ size_t a_rowtile(const Unit& u) const { return (size_t)u.pm; }
    __device__ __forceinline__ const char* b_ptr(const Unit& u) const { return B + (size_t)u.e * bstride + (size_t)u.pn * BM * ldb * eb; }
};

template <class Epi, class Sched, bool ALIGN_EPI>
__device__ __forceinline__ void gemm_phase(LAS unsigned char* lds, const char* Abase, int lda, int ldb, int K, const Sched& S, const Epi& E) {
    int tid_ = threadIdx.x; asm volatile("" : "+v"(tid_));
    const int tid = tid_, wid = __builtin_amdgcn_readfirstlane(tid >> 6), lane = tid & 63, wr = wid >> 2, wc = wid & 3, fr = lane & 15, fq = lane >> 4;
    int Kv_ = K; if (K <= 256) asm volatile("" : "+s"(Kv_));
    constexpr int EB = Epi::FP8 ? 1 : 2;
    const int nt = Kv_ / (128 / EB);
    int RA[2], CA[2]; unsigned voffB[2], voffA[2];
#pragma unroll
    for (int i = 0; i < 2; ++i) { int R, C; stage_rc(tid * 16 + i * 8192, R, C); RA[i] = R; CA[i] = C; const int Rb = Epi::PERM ? ((R & ~31) + perm32(R & 31)) : R; voffB[i] = (unsigned)(Rb * ldb * EB + C * 2); voffA[i] = (unsigned)(R * lda * EB + C * 2); }
    const size_t kstep = (size_t)(BK * 2);
    const size_t hstepB = (size_t)HALF * ldb * EB, hstepA = (size_t)HALF * lda * EB, tstepA = 2 * hstepA;
    const unsigned ldsw = (unsigned)wid * 1024u;
    const int aoff = lds_byte(wr * 64 + fr, fq * 8), boff = lds_byte(wc * 32 + fr, fq * 8);
#define PG8_SA(b, h) (((b) * 2 + (h)) * HTB)
#define PG8_SB(b, h) ((4 + (b) * 2 + (h)) * HTB)
#define PG8_STAGE_B(bufoff, gbase) do { _Pragma("unroll") for (int _i = 0; _i < 2; ++_i) \
        __builtin_amdgcn_global_load_lds((const unsigned*)((const char*)(gbase) + voffB[_i]), (LAS unsigned*)(lds + (bufoff) + ldsw + _i * 8192), 16, 0, 0); } while (0)
#define PG8_GL(src, bufoff) __builtin_amdgcn_global_load_lds((const unsigned*)(src), (LAS unsigned*)(lds + (bufoff) + ldsw + _i * 8192), 16, 0, 0)
#define PG8_STAGE_A(bufoff, h, nx, kb) do { \
        if constexpr (Sched::GATHER) { if (nx) { _Pragma("unroll") for (int _i = 0; _i < 2; ++_i) PG8_GL(Abase + (kb) + oAn[h][_i], bufoff); } \
                                       else    { _Pragma("unroll") for (int _i = 0; _i < 2; ++_i) PG8_GL(Abase + (kb) + oAc[h][_i], bufoff); } } \
        else { const char* _b = ((nx) ? nA : cA) + (h) * hstepA + (kb); _Pragma("unroll") for (int _i = 0; _i < 2; ++_i) PG8_GL(_b + voffA[_i], bufoff); } } while (0)
#define PG8_LDA(dst, b, h) do { _Pragma("unroll") for (int m = 0; m < 4; ++m) { if constexpr (Epi::FP8) { dst##8[m].lo = *(const LAS v4i_t*)(lds + PG8_SA(b, h) + aoff + m * 2048); dst##8[m].hi = *(const LAS v4i_t*)(lds + PG8_SA(b, h) + aoff + m * 2048 + 1024); } \
        else { _Pragma("unroll") for (int k = 0; k < 2; ++k) dst[m][k] = *(const LAS bf16x8*)(lds + PG8_SA(b, h) + aoff + m * 2048 + k * 1024); } } } while (0)
#define PG8_LDB(dst, b, h) do { _Pragma("unroll") for (int n = 0; n < 2; ++n) { if constexpr (Epi::FP8) { dst##8[n].lo = *(const LAS v4i_t*)(lds + PG8_SB(b, h) + boff + n * 2048); dst##8[n].hi = *(const LAS v4i_t*)(lds + PG8_SB(b, h) + boff + n * 2048 + 1024); } \
        else { _Pragma("unroll") for (int k = 0; k < 2; ++k) dst[n][k] = *(const LAS bf16x8*)(lds + PG8_SB(b, h) + boff + n * 2048 + k * 1024); } } } while (0)
#define PG8_MMA(ai, bj, At, Bt) do { __builtin_amdgcn_s_setprio(1); _Pragma("unroll") for (int m = 0; m < 4; ++m) _Pragma("unroll") for (int n = 0; n < 2; ++n) { \
        if constexpr (Epi::FP8) asm volatile("v_mfma_f32_16x16x128_f8f6f4 %0, %1, %2, %0" : "+v"(acc[ai][bj][m][n]) : "v"(Bt##8[n]), "v"(At##8[m]));     \
        else { _Pragma("unroll") for (int k = 0; k < 2; ++k) acc[ai][bj][m][n] = __builtin_amdgcn_mfma_f32_16x16x32_bf16(Bt[n][k], At[m][k], acc[ai][bj][m][n], 0, 0, 0); } } \
        __builtin_amdgcn_s_setprio(0); } while (0)
#define PG8_WAIT_V(n) asm volatile("s_waitcnt vmcnt(" #n ")" ::: "memory")
#define PG8_WAIT_L(n) asm volatile("s_waitcnt lgkmcnt(" #n ")" ::: "memory")
#define PG8_BAR __builtin_amdgcn_s_barrier()
#define PG8_SCHED __builtin_amdgcn_sched_barrier(0)
    Unit cur, nxt; int ui = 0;
    if (!S.next(0, cur)) return;
    f32x4 acc[2][2][4][2];
#pragma unroll
    for (int a = 0; a < 2; ++a)
#pragma unroll
        for (int b = 0; b < 2; ++b)
#pragma unroll
            for (int m = 0; m < 4; ++m)
#pragma unroll
                for (int n = 0; n < 2; ++n) acc[a][b][m][n] = (f32x4){0.f, 0.f, 0.f, 0.f};
    typedef int v8i_t __attribute__((ext_vector_type(8))); typedef int v4i_t __attribute__((ext_vector_type(4)));
    bf16x8 At[4][2], B0[2][2], B1[2][2]; v8i_t At8[4], B08[2], B18[2];
    float rsv[8];
    if constexpr (Epi::KROT > 0) E.preload(cur, wr, fr, rsv);
#define PG8_KO(x) ((Epi::KROT > 0) ? (size_t)(((x) + Epi::KROT) & (nt - 1)) * kstep : (size_t)(x) * kstep)
    unsigned oAc[2][2], oAn[2][2];
    S.a_offs(cur, RA, CA, oAc);
    const char* cB = S.b_ptr(cur); const char* cA = Abase + S.a_rowtile(cur) * tstepA; const char* nA = cA;
    PG8_STAGE_B(PG8_SB(0, 0), cB + PG8_KO(0)); PG8_STAGE_B(PG8_SB(0, 1), cB + hstepB + PG8_KO(0)); PG8_STAGE_A(PG8_SA(0, 0), 0, false, PG8_KO(0)); PG8_STAGE_A(PG8_SA(0, 1), 1, false, PG8_KO(0));
    if (wr == 1) PG8_BAR;
    PG8_WAIT_V(2); PG8_BAR;
    PG8_STAGE_B(PG8_SB(1, 0), cB + PG8_KO(1)); PG8_STAGE_A(PG8_SA(1, 0), 0, false, PG8_KO(1)); PG8_STAGE_B(PG8_SB(1, 1), cB + hstepB + PG8_KO(1));
    PG8_WAIT_V(6); PG8_BAR;
    for (;;) {
        const bool has_next = S.next(ui + 1, nxt);
        const char* nB = cB; nA = cA;
        if (has_next) { S.a_offs(nxt, RA, CA, oAn); nB = S.b_ptr(nxt); nA = Abase + S.a_rowtile(nxt) * tstepA; }
        else if constexpr (Sched::GATHER) {
#pragma unroll
            for (int h = 0; h < 2; ++h)
#pragma unroll
                for (int i = 0; i < 2; ++i) oAn[h][i] = oAc[h][i];
        }
#pragma nounroll
        for (int t = 0; t < nt; t += 2) {
            const bool last = (t == nt - 2);
            const size_t ka1 = PG8_KO(t + 1);
            const size_t ka2 = last ? PG8_KO(0) : PG8_KO(t + 2), ka3 = last ? PG8_KO(1) : PG8_KO(t + 3);
            const char* b2 = (last ? nB : cB) + ka2; const char* b3 = (last ? nB : cB) + ka3;
            if constexpr (Epi::KROT > 0) { if (t == nt - Epi::KROT) E.midk(acc, rsv); }
            PG8_LDB(B0, 0, 0); PG8_LDB(B1, 0, 1); PG8_SCHED; PG8_LDA(At, 0, 0); PG8_STAGE_A(PG8_SA(1, 1), 1, false, ka1);
            PG8_WAIT_V(8); PG8_WAIT_L(0); PG8_BAR; PG8_MMA(0, 0, At, B0); PG8_MMA(0, 1, At, B1); PG8_BAR; PG8_SCHED;
            PG8_LDA(At, 0, 1); PG8_STAGE_B(PG8_SB(0, 0), b2); PG8_STAGE_B(PG8_SB(0, 1), b2 + hstepB); PG8_STAGE_A(PG8_SA(0, 0), 0, last, ka2);
            PG8_WAIT_V(8); PG8_WAIT_L(0); PG8_BAR; PG8_MMA(1, 0, At, B0); PG8_MMA(1, 1, At, B1); PG8_BAR; PG8_SCHED;
            PG8_LDB(B0, 1, 0); PG8_LDB(B1, 1, 1); PG8_SCHED; PG8_LDA(At, 1, 0); PG8_STAGE_A(PG8_SA(0, 1), 1, last, ka2);
            PG8_WAIT_V(8); PG8_WAIT_L(0); PG8_BAR; PG8_MMA(0, 0, At, B0); PG8_MMA(0, 1, At, B1); PG8_BAR; PG8_SCHED;
            PG8_LDA(At, 1, 1); PG8_STAGE_B(PG8_SB(1, 0), b3); PG8_STAGE_B(PG8_SB(1, 1), b3 + hstepB); PG8_STAGE_A(PG8_SA(1, 0), 0, last, ka3);
            PG8_WAIT_V(8); PG8_WAIT_L(0); PG8_BAR; PG8_MMA(1, 0, At, B0); PG8_MMA(1, 1, At, B1); PG8_BAR; PG8_SCHED;
        }
        if constexpr (ALIGN_EPI) { if (wr == 0) PG8_BAR; }
        if constexpr (Epi::FP8) asm volatile("s_nop 15\n\ts_nop 15" ::: "memory");
        E(acc, cur, wr, wc, fr, fq);
        if (!has_next) break;
#pragma unroll
        for (int a = 0; a < 2; ++a)
#pragma unroll
            for (int b = 0; b < 2; ++b)
#pragma unroll
                for (int m = 0; m < 4; ++m)
#pragma unroll
                    for (int n = 0; n < 2; ++n) acc[a][b][m][n] = (f32x4){0.f, 0.f, 0.f, 0.f};
        cur = nxt; cB = nB; cA = nA; ++ui;
        if constexpr (Epi::KROT > 0) E.preload(cur, wr, fr, rsv);
        if constexpr (Sched::GATHER) {
#pragma unroll
            for (int h = 0; h < 2; ++h)
#pragma unroll
                for (int i = 0; i < 2; ++i) oAc[h][i] = oAn[h][i];
        }
        if constexpr (ALIGN_EPI) { if (wr == 1) PG8_BAR; }
    }
    PG8_WAIT_V(0);
    if constexpr (!ALIGN_EPI) { if (wr == 0) PG8_BAR; }
    PG8_BAR;
#undef PG8_KO
#undef PG8_SA
#undef PG8_SB
#undef PG8_STAGE_A
#undef PG8_GL
#undef PG8_STAGE_B
#undef PG8_LDA
#undef PG8_LDB
#undef PG8_MMA
#undef PG8_WAIT_V
#undef PG8_WAIT_L
#undef PG8_BAR
#undef PG8_SCHED
}

typedef f32x4 Acc[2][2][4][2];
#define EPI_ROWS(ai, m) ((ai) * HALF + wr * 64 + (m) * 16 + fr)
#define EPI_COL(bj, n) ((bj) * HALF + wc * 32 + (n) * 16 + 4 * fq)
__device__ __forceinline__ void st4(bf16* p, f32x4 v) { u32x2 w; w.x = cvtpk(v[0], v[1]); w.y = cvtpk(v[2], v[3]); *(u32x2*)p = w; }
#define EPI_COLP(bj) ((bj) * HALF + wc * 32 + 8 * fq)
__device__ __forceinline__ void st16_wt(void* p, u32x4 w) { asm volatile("global_store_dwordx4 %0, %1, off sc1\n\ts_nop 1" :: "v"(p), "v"(w)); }
__device__ __forceinline__ void st8(bf16* p, f32x4 a, f32x4 b) { u32x4 w; w.x = cvtpk(a[0], a[1]); w.y = cvtpk(a[2], a[3]); w.z = cvtpk(b[0], b[1]); w.w = cvtpk(b[2], b[3]); *(u32x4*)p = w; }
__device__ __forceinline__ void st8nt(bf16* p, f32x4 a, f32x4 b) { u32x4 w; w.x = cvtpk(a[0], a[1]); w.y = cvtpk(a[2], a[3]); w.z = cvtpk(b[0], b[1]); w.w = cvtpk(b[2], b[3]); __builtin_nontemporal_store(w, (u32x4*)p); }
__device__ __forceinline__ void st8w(bf16* p, f32x4 a, f32x4 b) { u32x4 w; w.x = cvtpk(a[0], a[1]); w.y = cvtpk(a[2], a[3]); w.z = cvtpk(b[0], b[1]); w.w = cvtpk(b[2], b[3]); st16_wt(p, w); }
__device__ __forceinline__ float sq4(f32x4 v) { return (v[0] * v[0] + v[1] * v[1]) + (v[2] * v[2] + v[3] * v[3]); }

struct EpiInProj {
    static constexpr bool PERM = true; static constexpr int KROT = 0; static constexpr bool FP8 = false;
    bf16 *QD, *KD, *VD, *CQ, *CKV, *KM; float *SSQQ, *SSQKV; const float *rcos, *rsin; unsigned* kmaxw;
    __device__ __forceinline__ void operator()(const Acc& acc, const Unit& u, int wr, int wc, int fr, int fq) const {
        const int pn = u.pn;
        if (pn < 6) {
            bf16* base = QD + (size_t)(pn >> 1) * ((WS_KD - WS_QD) / 2); const float sc = pn < 2 ? QS_D : 1.f; const int cb = (pn & 1) * BM;
#pragma unroll
            for (int ai = 0; ai < 2; ++ai)
#pragma unroll
                for (int m = 0; m < 4; ++m) { bf16* rowp = base + (size_t)(u.pm * BM + EPI_ROWS(ai, m)) * 512 + cb;
#pragma unroll
                    for (int bj = 0; bj < 2; ++bj) { if (pn < 2) st8nt(rowp + EPI_COLP(bj), acc[ai][bj][m][0] * sc, acc[ai][bj][m][1] * sc); else st8(rowp + EPI_COLP(bj), acc[ai][bj][m][0] * sc, acc[ai][bj][m][1] * sc); } }
            if (pn == 2 || pn == 3) {
#pragma unroll
                for (int bj = 0; bj < 2; ++bj) { float mx = 0.f;
#pragma unroll
                    for (int ai = 0; ai < 2; ++ai)
#pragma unroll
                        for (int m = 0; m < 4; ++m) { float q = sq4(acc[ai][bj][m][0]) + sq4(acc[ai][bj][m][1]); q += __shfl_xor(q, 16); q += __shfl_xor(q, 32); mx = fmaxf(mx, q); }
                    mx = fmaxf(mx, __shfl_xor(mx, 1)); mx = fmaxf(mx, __shfl_xor(mx, 2)); mx = fmaxf(mx, __shfl_xor(mx, 4)); mx = fmaxf(mx, __shfl_xor(mx, 8));
                    const int g32 = (cb + bj * HALF + wc * 32) >> 5;
                    if (fr == 0 && fq == 0) atomicMax(kmaxw + (u.pm >> 5) * 16 + g32, __float_as_uint(mx)); }
            }
        } else if (pn == 6) {
#pragma unroll
            for (int ai = 0; ai < 2; ++ai)
#pragma unroll
                for (int m = 0; m < 4; ++m) { const int row = u.pm * BM + EPI_ROWS(ai, m); bf16* rowp = CQ + (size_t)row * 256; float s = 0.f;
#pragma unroll
                    for (int bj = 0; bj < 2; ++bj) { st8(rowp + EPI_COLP(bj), acc[ai][bj][m][0], acc[ai][bj][m][1]); s += sq4(acc[ai][bj][m][0]) + sq4(acc[ai][bj][m][1]); }
                    s += __shfl_xor(s, 16); s += __shfl_xor(s, 32);
                    if (fq == 0) SSQQ[(size_t)row * 4 + wc] = s; }
        } else {
#pragma unroll
            for (int ai = 0; ai < 2; ++ai)
#pragma unroll
                for (int m = 0; m < 4; ++m) { const int row = u.pm * BM + EPI_ROWS(ai, m); bf16* rowp = CKV + (size_t)row * 128;
                    st8(rowp + EPI_COLP(0), acc[ai][0][m][0], acc[ai][0][m][1]);
                    float s = sq4(acc[ai][0][m][0]) + sq4(acc[ai][0][m][1]);
                    s += __shfl_xor(s, 16); s += __shfl_xor(s, 32);
                    if (fq == 0) SSQKV[(size_t)row * 4 + wc] = s;
                    if (wc == 0) {
                        const f32x4 a0 = acc[ai][1][m][0], a1 = acc[ai][1][m][1]; f32x4 o0, o1;
#pragma unroll
                        for (int q = 0; q < 4; ++q) { o0[q] = __shfl_xor(a0[q], 32); o1[q] = __shfl_xor(a1[q], 32); }
                        const int i0 = 8 * (fq & 1);
                        const f32x4 c0 = *(const f32x4*)(rcos + (size_t)row * 16 + i0), c1 = *(const f32x4*)(rcos + (size_t)row * 16 + i0 + 4);
                        const f32x4 s0 = *(const f32x4*)(rsin + (size_t)row * 16 + i0), s1 = *(const f32x4*)(rsin + (size_t)row * 16 + i0 + 4);
                        const float sg = (fq < 2) ? -1.f : 1.f;
                        const f32x4 r0 = a0 * c0 + o0 * s0 * sg, r1 = a1 * c1 + o1 * s1 * sg;
                        bf16* kp = KM + (size_t)row * 768 + 64 + 8 * fq;
#pragma unroll
                        for (int h = 0; h < 8; ++h) st8(kp + h * 96, r0, r1);
                    }
                    if (m & 1) asm volatile("" ::: "memory"); }
        }
    }
};
struct EpiUpQ {
    static constexpr bool PERM = true; static constexpr int KROT = 0; static constexpr bool FP8 = false;
    bf16* QM; const float* SSQQ; const float *rcos, *rsin;
    __device__ __forceinline__ void operator()(const Acc& acc, const Unit& u, int wr, int wc, int fr, int fq) const {
        float rsv[8];
#pragma unroll
        for (int i = 0; i < 8; ++i) { const f32x4 p = *(const f32x4*)(SSQQ + (size_t)(u.pm * BM + EPI_ROWS(i >> 2, i & 3)) * 4); rsv[i] = __builtin_amdgcn_rsqf(((p[0] + p[1]) + (p[2] + p[3])) * (1.f / 256.f) + EPS) * QS_M; }
#pragma unroll
        for (int i = 0; i < 8; ++i) { const int ai = i >> 2, m = i & 3; const int row = u.pm * BM + EPI_ROWS(ai, m); const float rs = rsv[i];
            bf16* rowp = QM + (size_t)row * 768 + u.pn * BM;
#pragma unroll
            for (int bj = 0; bj < 2; ++bj) { const int g32 = (u.pn * BM + bj * HALF + wc * 32) >> 5;
                f32x4 v0 = acc[ai][bj][m][0] * rs, v1 = acc[ai][bj][m][1] * rs;
                if (g32 % 3 == 2) { f32x4 o0, o1;
#pragma unroll
                    for (int q = 0; q < 4; ++q) { o0[q] = __shfl_xor(v0[q], 32); o1[q] = __shfl_xor(v1[q], 32); }
                    const int i0 = 8 * (fq & 1);
                    const f32x4 c0 = *(const f32x4*)(rcos + (size_t)row * 16 + i0), c1 = *(const f32x4*)(rcos + (size_t)row * 16 + i0 + 4);
                    const f32x4 s0 = *(const f32x4*)(rsin + (size_t)row * 16 + i0), s1 = *(const f32x4*)(rsin + (size_t)row * 16 + i0 + 4);
                    const float sg = (fq < 2) ? -1.f : 1.f;
                    v0 = v0 * c0 + o0 * s0 * sg; v1 = v1 * c1 + o1 * s1 * sg; }
                st8nt(rowp + EPI_COLP(bj), v0, v1); }
            if (i & 1) asm volatile("" ::: "memory"); }
    }
};
struct EpiUpKV {
    static constexpr bool PERM = true; static constexpr int KROT = 0; static constexpr bool FP8 = false;
    bf16 *KM, *VM; const float* SSQKV;
    __device__ __forceinline__ void operator()(const Acc& acc, const Unit& u, int wr, int wc, int fr, int fq) const {
        float rsv[8];
#pragma unroll
        for (int i = 0; i < 8; ++i) { const f32x4 p = *(const f32x4*)(SSQKV + (size_t)(u.pm * BM + EPI_ROWS(i >> 2, i & 3)) * 4); rsv[i] = __builtin_amdgcn_rsqf(((p[0] + p[1]) + (p[2] + p[3])) * (1.f / 128.f) + EPS); }
#pragma unroll
        for (int i = 0; i < 8; ++i) { const int ai = i >> 2, m = i & 3; const int row = u.pm * BM + EPI_ROWS(ai, m); const float rs = rsv[i];
#pragma unroll
            for (int bj = 0; bj < 2; ++bj) { const int head = u.pn * 2 + bj; const int w32 = wc * 32;
                bf16* dst = (w32 < 64) ? KM + (size_t)row * 768 + head * 96 + w32 : VM + (size_t)row * 512 + head * 64 + (w32 - 64);
                st8(dst + 8 * fq, acc[ai][bj][m][0] * rs, acc[ai][bj][m][1] * rs); } }
    }
};
struct EpiMemKV {
    static constexpr bool PERM = true; static constexpr int KROT = 0; static constexpr bool FP8 = false;
    bf16 *KC, *VC;
    __device__ __forceinline__ void operator()(const Acc& acc, const Unit& u, int wr, int wc, int fr, int fq) const {
        bf16* base = KC + (size_t)(u.pn >> 1) * ((WS_VC - WS_KC) / 2); const int cb = (u.pn & 1) * BM;
#pragma unroll
        for (int ai = 0; ai < 2; ++ai)
#pragma unroll
            for (int m = 0; m < 4; ++m) { bf16* rowp = base + (size_t)(u.pm * BM + EPI_ROWS(ai, m)) * 512 + cb;
#pragma unroll
                for (int bj = 0; bj < 2; ++bj) st8(rowp + EPI_COLP(bj), acc[ai][bj][m][0], acc[ai][bj][m][1]); }
    }
};
template <bool RES_F32, int KROT_ = 0, bool FP8_ = false> struct EpiResid {
    static constexpr bool PERM = true; static constexpr int KROT = KROT_; static constexpr bool FP8 = FP8_;
    const float* resf; const bf16* resb; bf16* XO; float* SSQ; const float* ssqm; unsigned char* XQ; float ascale; const float* rscale;
    __device__ __forceinline__ void preload(const Unit& u, int wr, int fr, float (&rsv)[8]) const {
#pragma unroll
        for (int i = 0; i < 8; ++i) { const f32x4* sp = (const f32x4*)(ssqm + (size_t)(u.pm * BM + EPI_ROWS(i >> 2, i & 3)) * 8); const f32x4 a = sp[0] + sp[1]; rsv[i] = __builtin_amdgcn_rsqf(((a[0] + a[1]) + (a[2] + a[3])) * (1.f / 512.f) + EPS); }
    }
    __device__ __forceinline__ void midk(Acc& acc, const float (&rsv)[8]) const {
        if constexpr (FP8) { asm volatile("s_nop 15\n\ts_nop 15" ::: "memory"); __builtin_amdgcn_sched_barrier(0); }
#pragma unroll
        for (int i = 0; i < 8; ++i)
#pragma unroll
            for (int bj = 0; bj < 2; ++bj)
#pragma unroll
                for (int n = 0; n < 2; ++n) acc[i >> 2][bj][i & 3][n] *= rsv[i];
    }
    __device__ __forceinline__ void operator()(const Acc& acc, const Unit& u, int wr, int wc, int fr, int fq) const {
#pragma unroll
        for (int ai = 0; ai < 2; ++ai)
#pragma unroll
            for (int mp = 0; mp < 2; ++mp) { unsigned xq[2][2][2];
#pragma unroll
                for (int k = 0; k < 2; ++k) { const int m = 2 * mp + k; const int row = u.pm * BM + EPI_ROWS(ai, m); const size_t ro = (size_t)row * DM + u.pn * BM; float s = 0.f;
#pragma unroll
                    for (int bj = 0; bj < 2; ++bj) { const int c = EPI_COLP(bj); f32x4 r0, r1;
                        if (RES_F32) { r0 = *(const f32x4*)(resf + ro + c); r1 = *(const f32x4*)(resf + ro + c + 4); }
                        else { const u32x4 w = *(const u32x4*)(resb + ro + c); r0 = (f32x4){bf_lo(w.x), bf_hi(w.x), bf_lo(w.y), bf_hi(w.y)}; r1 = (f32x4){bf_lo(w.z), bf_hi(w.z), bf_lo(w.w), bf_hi(w.w)};
                            if (rscale) { const float q = rscale[row]; r0 = r0 * q; r1 = r1 * q; } }
                        const f32x4 v0 = r0 + acc[ai][bj][m][0] * ascale, v1 = r1 + acc[ai][bj][m][1] * ascale; st8w(XO + ro + c, v0, v1); s += sq4(v0) + sq4(v1);
                        if (!RES_F32 && XQ) { unsigned w0 = 0, w1 = 0; w0 = __builtin_amdgcn_cvt_pk_fp8_f32(v0[0], v0[1], w0, false); w0 = __builtin_amdgcn_cvt_pk_fp8_f32(v0[2], v0[3], w0, true);
                            w1 = __builtin_amdgcn_cvt_pk_fp8_f32(v1[0], v1[1], w1, false); w1 = __builtin_amdgcn_cvt_pk_fp8_f32(v1[2], v1[3], w1, true); xq[k][bj][0] = w0; xq[k][bj][1] = w1; } }
                    s += __shfl_xor(s, 16); s += __shfl_xor(s, 32);
                    if (fq == 0) SSQ[(size_t)row * 16 + u.pn * 4 + wc] = s; }
                if (!RES_F32 && XQ) {
                    const int m = 2 * mp + (fq & 1); const size_t ro = (size_t)(u.pm * BM + EPI_ROWS(ai, m)) * DM + u.pn * BM;
#pragma unroll
                    for (int bj = 0; bj < 2; ++bj) { const auto a0 = __builtin_amdgcn_permlane16_swap(xq[0][bj][0], xq[1][bj][0], false, false), a1 = __builtin_amdgcn_permlane16_swap(xq[0][bj][1], xq[1][bj][1], false, false);
                        *(u32x4*)(XQ + ro + bj * HALF + wc * 32 + 8 * (fq & ~1)) = (u32x4){a0[0], a1[0], a0[1], a1[1]}; } }
                asm volatile("" ::: "memory"); }
    }
};
struct EpiCrossQ {
    static constexpr bool PERM = true; static constexpr int KROT = 0; static constexpr bool FP8 = false;
    bf16* QC; const float* SSQ1;
    __device__ __forceinline__ void operator()(const Acc& acc, const Unit& u, int wr, int wc, int fr, int fq) const {
        float rsv[8];
#pragma unroll
        for (int hb = 0; hb < 2; ++hb) {
#pragma unroll
            for (int i = 4 * hb; i < 4 * hb + 4; ++i) { const f32x4* pp = (const f32x4*)(SSQ1 + (size_t)(u.pm * BM + EPI_ROWS(i >> 2, i & 3)) * 16); const f32x4 p = (pp[0] + pp[1]) + (pp[2] + pp[3]);
                rsv[i] = __builtin_amdgcn_rsqf(((p[0] + p[1]) + (p[2] + p[3])) * (1.f / 1024.f) + EPS) * QS_C; }
            asm volatile("" ::: "memory"); }
#pragma unroll
        for (int i = 0; i < 8; ++i) { const int ai = i >> 2, m = i & 3; bf16* rowp = QC + (size_t)(u.pm * BM + EPI_ROWS(ai, m)) * 512 + u.pn * BM;
#pragma unroll
            for (int bj = 0; bj < 2; ++bj) st8(rowp + EPI_COLP(bj), acc[ai][bj][m][0] * rsv[i], acc[ai][bj][m][1] * rsv[i]); }
    }
};
struct EpiMoeUp {
    static constexpr bool PERM = false; static constexpr int KROT = 0; static constexpr bool FP8 = true;
    bf16* H; const int* list; const float* RS2; const LAS int* TP;
    __device__ __forceinline__ void operator()(const Acc& acc, const Unit& u, int wr, int wc, int fr, int fq) const {
        const int j = u.pm - TP[u.e];
        float rsv[8];
#pragma unroll
        for (int i = 0; i < 8; ++i) { const int idx = j * BM + EPI_ROWS(i >> 2, i & 3); rsv[i] = (idx < u.cnt) ? RS2[(size_t)u.e * T + idx] * (1.f / 32.f) : 0.f; }
#pragma unroll
        for (int ai = 0; ai < 2; ++ai)
#pragma unroll
            for (int bj = 0; bj < 2; ++bj) { const int g32 = (u.pn * BM + bj * HALF + wc * 32) >> 5; unsigned w[4];
#pragma unroll
                for (int m = 0; m < 4; ++m) { const float rs = rsv[ai * 4 + m];
                    const f32x4 g = acc[ai][bj][m][0] * rs, up = acc[ai][bj][m][1] * rs; f32x4 h;
#pragma unroll
                    for (int q = 0; q < 4; ++q) h[q] = g[q] * up[q] * __builtin_amdgcn_rcpf(1.f + __builtin_amdgcn_exp2f(-g[q] * LOG2E));
                    unsigned w_ = 0; w_ = __builtin_amdgcn_cvt_pk_fp8_f32(h[0], h[1], w_, false); w_ = __builtin_amdgcn_cvt_pk_fp8_f32(h[2], h[3], w_, true); w[m] = w_; }
                const auto p01 = __builtin_amdgcn_permlane16_swap(w[0], w[1], false, false), p23 = __builtin_amdgcn_permlane16_swap(w[2], w[3], false, false);
                const auto q0 = __builtin_amdgcn_permlane32_swap(p01[0], p23[0], false, false), q1 = __builtin_amdgcn_permlane32_swap(p01[1], p23[1], false, false);
                *(u32x4*)((unsigned char*)H + (size_t)(u.pm * BM + EPI_ROWS(ai, fq)) * EFF + 16 * g32) = (u32x4){q0[0], q1[0], q0[1], q1[1]}; }
    }
};
struct EpiMoeDown {
    static constexpr bool PERM = true; static constexpr int KROT = 0; static constexpr bool FP8 = true;
    bf16* Y;
    __device__ __forceinline__ void operator()(const Acc& acc, const Unit& u, int wr, int wc, int fr, int fq) const {
#pragma unroll
        for (int ai = 0; ai < 2; ++ai)
#pragma unroll
            for (int mp = 0; mp < 2; ++mp) {
#pragma unroll
                for (int bj = 0; bj < 2; ++bj) { unsigned w[2][2];
#pragma unroll
                    for (int k = 0; k < 2; ++k) { const f32x4 v0 = acc[ai][bj][2 * mp + k][0] * (1.f / 16.f), v1 = acc[ai][bj][2 * mp + k][1] * (1.f / 16.f); unsigned w0 = 0, w1 = 0;
                        w0 = __builtin_amdgcn_cvt_pk_fp8_f32(v0[0], v0[1], w0, false); w0 = __builtin_amdgcn_cvt_pk_fp8_f32(v0[2], v0[3], w0, true);
                        w1 = __builtin_amdgcn_cvt_pk_fp8_f32(v1[0], v1[1], w1, false); w1 = __builtin_amdgcn_cvt_pk_fp8_f32(v1[2], v1[3], w1, true); w[k][0] = w0; w[k][1] = w1; }
                    const auto r0 = __builtin_amdgcn_permlane16_swap(w[0][0], w[1][0], false, false), r1 = __builtin_amdgcn_permlane16_swap(w[0][1], w[1][1], false, false);
                    const int m = 2 * mp + (fq & 1);
                    *(u32x4*)((unsigned char*)Y + (size_t)(u.pm * BM + EPI_ROWS(ai, m)) * DM + u.pn * BM + bj * HALF + wc * 32 + 8 * (fq & ~1)) = (u32x4){r0[0], r1[0], r0[1], r1[1]}; } }
    }
};
}

namespace att {
typedef short v4i16_t __attribute__((ext_vector_type(4)));
__device__ __forceinline__ int crow(int r, int hi) { return (r & 3) + 8 * (r >> 2) + 4 * hi; }
__device__ __forceinline__ s16x4 vtr(const LAS unsigned char* p) { return __builtin_bit_cast(s16x4, __builtin_amdgcn_ds_read_tr16_b64_v4i16((LAS v4i16_t*)p)); }

template <int DQK, int NMAP, int DV, bool CAUSAL, bool ALIBI, int qpitch, int kpitch, int vpitch, class Epi, bool FAST = false>
__device__ __forceinline__ bool attn_unit(LAS unsigned char* lds, const bf16* Qp, const bf16* Kp, const bf16* Vp, int NT, int qrow0, float cb, const Epi& epi) {
    constexpr int KW = NMAP * DQK, KCH = KW / 8, KROWB = KW * 2 + 16, KTB = 64 * KROWB, VCH = DV / 8, VTB = 64 * DV * 2, NDB = DV / 32, NDK = DQK / 16;
    constexpr int NKC = (64 * KCH + 511) / 512, NVC = (64 * VCH + 511) / 512;
    static_assert(2 * KTB + 2 * VTB + 64 <= RING_BYTES, "attention LDS");
    int tid_ = threadIdx.x; asm volatile("" : "+v"(tid_));
    const int tid = tid_, lane = tid & 63, r32 = lane & 31, hi = lane >> 5; const int wid = __builtin_amdgcn_readfirstlane(tid >> 6);
    bf16x8 qf[NMAP][NDK];
    { const bf16* qrow = Qp + (size_t)(wid * 32 + r32) * qpitch;
#pragma unroll
      for (int mp = 0; mp < NMAP; ++mp)
#pragma unroll
          for (int d0 = 0; d0 < NDK; ++d0) qf[mp][d0] = *(const bf16x8*)(qrow + mp * DQK + d0 * 16 + hi * 8); }
    f32x16 O[NMAP][NDB]; float mrun[NMAP], lrun[NMAP];
#pragma unroll
    for (int mp = 0; mp < NMAP; ++mp) { mrun[mp] = -INFINITY; lrun[mp] = 0.f;
#pragma unroll
        for (int db = 0; db < NDB; ++db)
#pragma unroll
            for (int r = 0; r < 16; ++r) O[mp][db][r] = 0.f; }
    int kgo[NKC], klo[NKC], vgo[NVC], vlo[NVC]; bool kval[NKC], vval[NVC];
#pragma unroll
    for (int c = 0; c < NKC; ++c) { const int id = tid + 512 * c; kval[c] = id < 64 * KCH; const int row = id / KCH, cc = id % KCH; kgo[c] = row * kpitch + cc * 8; klo[c] = row * KROWB + cc * 16; }
#pragma unroll
    for (int c = 0; c < NVC; ++c) { const int id = tid + 512 * c; vval[c] = id < 64 * VCH; const int row = id / VCH, cc = id % VCH; vgo[c] = row * vpitch + cc * 8; vlo[c] = (cc >> 2) * 4096 + row * 64 + (cc & 3) * 16; }
    u32x4 kreg[NKC], vreg[NVC];
#define ATT_LOADG(t) do { _Pragma("unroll") for (int c = 0; c < NKC; ++c) if (kval[c]) kreg[c] = *(const u32x4*)(Kp + (size_t)(t) * 64 * kpitch + kgo[c]); \
        _Pragma("unroll") for (int c = 0; c < NVC; ++c) if (vval[c]) vreg[c] = *(const u32x4*)(Vp + (size_t)(t) * 64 * vpitch + vgo[c]); } while (0)
#define ATT_STORE(b) do { _Pragma("unroll") for (int c = 0; c < NKC; ++c) if (kval[c]) *(LAS u32x4*)(lds + (b) * KTB + klo[c]) = kreg[c]; \
        _Pragma("unroll") for (int c = 0; c < NVC; ++c) if (vval[c]) *(LAS u32x4*)(lds + 2 * KTB + (b) * VTB + vlo[c]) = vreg[c]; } while (0)
    ATT_LOADG(0); ATT_STORE(0); __syncthreads();
    const int afirst = qrow0 + wid * 32;
    float cbr[16];
#pragma unroll
    for (int r = 0; r < 16; ++r) cbr[r] = ALIBI ? cb * (float)crow(r, hi) : 0.f;
    const int vlane = (4 * hi + ((lane & 15) >> 2)) * 64 + (((lane >> 4) & 1) * 16 + (lane & 3) * 4) * 2;
    for (int t = 0; t < NT; ++t) {
        const int cur = t & 1;
        if (t + 1 < NT) ATT_LOADG(t + 1);
        const bool active = !CAUSAL || (64 * t <= afirst);
        if (active) {
            const LAS unsigned char* kb_ = lds + cur * KTB + r32 * KROWB + hi * 16;
            const LAS unsigned char* vb_ = lds + 2 * KTB + cur * VTB + vlane;
            const bool diag = CAUSAL && (64 * t + 63 > afirst);
#pragma unroll
            for (int mp = 0; mp < NMAP; ++mp) {
                f32x16 s[2];
#pragma unroll
                for (int kb = 0; kb < 2; ++kb) {
                    f32x16 a;
                    if (ALIBI) { const float tb = cb * (float)(64 * t + 32 * kb - qrow0 - 255);
#pragma unroll
                        for (int r = 0; r < 16; ++r) a[r] = cbr[r] + tb; }
                    else {
#pragma unroll
                        for (int r = 0; r < 16; ++r) a[r] = 0.f; }
#pragma unroll
                    for (int d0 = 0; d0 < NDK; ++d0) { const bf16x8 kf = *(const LAS bf16x8*)(kb_ + kb * 32 * KROWB + (mp * DQK + d0 * 16) * 2); a = __builtin_amdgcn_mfma_f32_32x32x16_bf16(kf, qf[mp][d0], a, 0, 0, 0); }
                    s[kb] = a; __builtin_amdgcn_sched_barrier(0);
                }
                if (diag) { int qi = afirst + r32; asm volatile("" : "+v"(qi));
#pragma unroll
                    for (int kb = 0; kb < 2; ++kb)
#pragma unroll
                        for (int r = 0; r < 16; ++r) { const int kj = 64 * t + 32 * kb + crow(r, hi); if (kj > qi) s[kb][r] = -INFINITY; } }
                float mnew = 0.f;
                if (!FAST) {
                float mx = fmaxf(s[0][0], s[1][0]);
#pragma unroll
                for (int r = 1; r < 16; ++r) mx = fmaxf(mx, fmaxf(s[0][r], s[1][r]));
                mx = fmaxf(mx, __shfl_xor(mx, 32));
                mnew = fmaxf(mrun[mp], mx);
                if (__any(mnew > mrun[mp])) {
                    const float alpha = __builtin_amdgcn_exp2f(mrun[mp] - mnew);
                    lrun[mp] *= alpha;
#pragma unroll
                    for (int db = 0; db < NDB; ++db)
#pragma unroll
                        for (int r = 0; r < 16; ++r) O[mp][db][r] *= alpha;
                    mrun[mp] = mnew;
                }
                }
                float ls = 0.f;
#pragma unroll
                for (int kb = 0; kb < 2; ++kb)
#pragma unroll
                    for (int r = 0; r < 16; ++r) { const float p = FAST ? __builtin_amdgcn_exp2f(s[kb][r]) : __builtin_amdgcn_exp2f(s[kb][r] - mnew); s[kb][r] = p; ls += p; }
                lrun[mp] += ls;
#pragma unroll
                for (int s4 = 0; s4 < 4; ++s4) {
                    const int kb = s4 >> 1, hf = (s4 & 1) * 8;
                    u32x4 pw; pw.x = cvtpk(s[kb][hf + 0], s[kb][hf + 1]); pw.y = cvtpk(s[kb][hf + 2], s[kb][hf + 3]); pw.z = cvtpk(s[kb][hf + 4], s[kb][hf + 5]); pw.w = cvtpk(s[kb][hf + 6], s[kb][hf + 7]);
                    const bf16x8 pf = __builtin_bit_cast(bf16x8, pw);
#pragma unroll
                    for (int db = 0; db < NDB; ++db) {
                        const s16x4 lo = vtr(vb_ + db * 4096 + s4 * 1024), hh = vtr(vb_ + db * 4096 + s4 * 1024 + 512);
                        const bf16x8 vf = (bf16x8){lo[0], lo[1], lo[2], lo[3], hh[0], hh[1], hh[2], hh[3]};
                        O[mp][db] = __builtin_amdgcn_mfma_f32_32x32x16_bf16(vf, pf, O[mp][db], 0, 0, 0);
                    }
                }
            }
        }
        if (t + 1 < NT) ATT_STORE(cur ^ 1);
        __syncthreads();
    }
#undef ATT_LOADG
#undef ATT_STORE
    float ltot[NMAP];
#pragma unroll
    for (int mp = 0; mp < NMAP; ++mp) ltot[mp] = lrun[mp] + __shfl_xor(lrun[mp], 32);
    epi(O, ltot, wid * 32 + r32, r32, hi, lds + wid * 4608);
    if (!FAST) return false;
    unsigned mxb = 0u;
#pragma unroll
    for (int mp = 0; mp < NMAP; ++mp) { const unsigned lb = __float_as_uint(ltot[mp]) & 0x7fffffffu; mxb = mxb > lb ? mxb : lb; if (lb < 0x21800000u) mxb = 0x7f800000u;
#pragma unroll
        for (int db = 0; db < NDB; ++db)
#pragma unroll
            for (int r = 0; r < 16; ++r) { const unsigned ob = __float_as_uint(O[mp][db][r]) & 0x7fffffffu; mxb = mxb > ob ? mxb : ob; } }
    volatile LAS unsigned* vote = (volatile LAS unsigned*)(lds + 2 * KTB + 2 * VTB);
    if (lane == 0) vote[wid] = (__any(mxb >= 0x7f800000u)) ? 1u : 0u;
    __syncthreads();
    const u32x4 g0 = *(const LAS u32x4*)(lds + 2 * KTB + 2 * VTB), g1 = *(const LAS u32x4*)(lds + 2 * KTB + 2 * VTB + 16);
    const bool bad = (g0.x | g0.y | g0.z | g0.w | g1.x | g1.y | g1.z | g1.w) != 0u;
    __syncthreads();
    return bad;
}
}


namespace att2 {
#define A2_SBAR() __builtin_amdgcn_sched_barrier(0)
typedef short v4i16_t __attribute__((ext_vector_type(4)));
__device__ __forceinline__ float max3f(float a, float b, float c) { float r; asm("v_max3_f32 %0, %1, %2, %3" : "=v"(r) : "v"(a), "v"(b), "v"(c)); return r; }
__device__ __forceinline__ float fadd_s(float a, float b) { float r; asm("v_add_f32_e32 %0, %1, %2" : "=v"(r) : "v"(a), "v"(b)); return r; }
__device__ __forceinline__ float max2f(float a, float b) { float r; asm("v_max_f32_e32 %0, %1, %2" : "=v"(r) : "v"(a), "v"(b)); return r; }
__device__ __forceinline__ int crow(int r, int hi) { return (r & 3) + 8 * (r >> 2) + 4 * hi; }
__device__ __forceinline__ s16x4 vtr(const LAS unsigned char* p) { return __builtin_bit_cast(s16x4, __builtin_amdgcn_ds_read_tr16_b64_v4i16((LAS v4i16_t*)p)); }
__device__ __forceinline__ float xhalf_max(float m) { auto rr = __builtin_amdgcn_permlane32_swap(__float_as_uint(m), __float_as_uint(m), false, false); return max2f(__uint_as_float(rr[0]), __uint_as_float(rr[1])); }
__device__ __forceinline__ float xhalf_sum(float m) { auto rr = __builtin_amdgcn_permlane32_swap(__float_as_uint(m), __float_as_uint(m), false, false); return __uint_as_float(rr[0]) + __uint_as_float(rr[1]); }
__device__ __forceinline__ float rowmax32(const f32x16& p0, const f32x16& p1) {
    float a = max3f(p0[0], p0[1], p1[0]), b = max3f(p0[2], p0[3], p1[1]); a = max3f(a, p1[2], p1[3]);
#pragma unroll
    for (int r = 4; r < 16; r += 4) { a = max3f(a, p0[r], p0[r + 1]); b = max3f(b, p0[r + 2], p0[r + 3]); a = max3f(a, p1[r], p1[r + 1]); b = max3f(b, p1[r + 2], p1[r + 3]); }
    return xhalf_max(max2f(a, b));
}
__device__ __forceinline__ void glds16(const void* gsrc, unsigned lds_dst) { unsigned keep;
    asm volatile("s_mov_b32 %0, m0\n\ts_mov_b32 m0, %2\n\ts_nop 0\n\tglobal_load_lds_dwordx4 %1, off\n\ts_mov_b32 m0, %0" : "=&s"(keep) : "v"(gsrc), "s"(lds_dst) : "memory"); }
#define A2_PIN(x) asm volatile("" :: "v"(x))
constexpr float NEGM = -30000.f, THR = 6.f, SKIP_THR = 28.f;
constexpr int VTB = 8192;

template <int DQK, int NMAP, bool ALIBI, int qpitch, int kpitch, int vpitch, class Epi, int VAR = 0, bool CHK = true>
__device__ __forceinline__ bool unit(LAS unsigned char* lds, const bf16* Qp, const bf16* Kp, const bf16* Vp, int NT, int qrow0, float cb, float kmax0, float kmax1, const Epi& epi) {
    constexpr int KW = NMAP * DQK, KCH = KW / 8, KROWB = KW * 2 + 16, KTB = 64 * KROWB, NDK = DQK / 16, NQ = 2 * NDK, KA = (NMAP == 1) ? 2 : 1;
    constexpr int NKS = (NMAP == 1) ? 6 : 3, NVS = (NMAP == 1) ? 4 : 2;
    constexpr int OFF_V = NKS * KTB, OFF_FLAG = OFF_V + NVS * VTB;
    static_assert(OFF_FLAG + 64 <= RING_BYTES - 8192, "attention LDS (the top 8 KiB of the ring hold the unit tables)");
    int tid_ = threadIdx.x; asm volatile("" : "+v"(tid_));
    const int tid = tid_, lane = tid & 63, r32 = lane & 31, hi = lane >> 5; const int wid = __builtin_amdgcn_readfirstlane(tid >> 6);
    constexpr int chki = CHK ? 1 : 0;
    bf16x8 qf[NMAP][NDK];
    { const bf16* qrow = Qp + (size_t)(wid * 32 + r32) * qpitch;
#pragma unroll
      for (int mp = 0; mp < NMAP; ++mp)
#pragma unroll
          for (int d0 = 0; d0 < NDK; ++d0) qf[mp][d0] = *(const bf16x8*)(qrow + mp * DQK + d0 * 16 + hi * 8); }
    f32x16 O[NMAP][2]; float mhat[NMAP], lsum[NMAP], fres[NMAP];
#pragma unroll
    for (int mp = 0; mp < NMAP; ++mp) { mhat[mp] = 0.f; lsum[mp] = 0.f; fres[mp] = 1.f;
#pragma unroll
        for (int db = 0; db < 2; ++db)
#pragma unroll
            for (int r = 0; r < 16; ++r) O[mp][db][r] = 0.f; }
    float qn[NMAP];
    if (ALIBI) {
#pragma unroll
        for (int mp = 0; mp < NMAP; ++mp) { float ss = 0.f;
#pragma unroll
            for (int d0 = 0; d0 < NDK; ++d0)
#pragma unroll
                for (int j = 0; j < 8; ++j) { const float v = __uint_as_float((unsigned)(unsigned short)qf[mp][d0][j] << 16); ss += v * v; }
            qn[mp] = sqrtf(xhalf_sum(ss)) * ((mp == 0) ? kmax0 : kmax1); }
    }
    constexpr int CPR = KCH + 1, KPIECES = (64 * CPR) / 64;
    int kgo[2];
#pragma unroll
    for (int c = 0; c < 2; ++c) { const int sl = 64 * (wid + 8 * c) + lane, row = sl / CPR, cc = sl % CPR; kgo[c] = row * kpitch + (cc == KCH ? 0 : cc) * 8; }
    const int vgo = (8 * wid + (lane >> 3)) * vpitch + ((((lane >> 2) & 1) ^ ((lane >> 4) & 1)) * 4 + (lane & 3)) * 8;
    const unsigned lds0 = (unsigned)(uintptr_t)lds;
#define A2_DMAK(u) do { if (VAR == 2) break; const bf16* kt_ = Kp + (size_t)(NT - 1 - (u)) * 64 * kpitch; const unsigned kd_ = (unsigned)__builtin_amdgcn_readfirstlane((int)(lds0 + ((u) % NKS) * KTB + wid * 1024)); \
        glds16(kt_ + kgo[0], kd_); if (wid + 8 < KPIECES) glds16(kt_ + kgo[1], kd_ + 8192u); } while (0)
#define A2_DMAV(u) if (VAR != 2) glds16(Vp + (size_t)(NT - 1 - (u)) * 64 * vpitch + vgo, (unsigned)__builtin_amdgcn_readfirstlane((int)(lds0 + OFF_V + ((u) % NVS) * VTB + wid * 1024)))
#define A2_DMAK1(uu, c) do { if (VAR == 2) break; const int ta_ = ((uu) < NT) ? (uu) : NT - 1; const bf16* kt_ = Kp + (size_t)(NT - 1 - ta_) * 64 * kpitch; \
        const unsigned kd_ = (unsigned)__builtin_amdgcn_readfirstlane((int)(lds0 + ((uu) % NKS) * KTB + wid * 1024)); \
        if ((c) == 0) glds16(kt_ + kgo[0], kd_); else if (wid + 8 < KPIECES) glds16(kt_ + kgo[1], kd_ + 8192u); } while (0)
#define A2_DMAV1(uu) do { if (VAR == 2) break; const int ta_ = ((uu) < NT) ? (uu) : NT - 1; \
        glds16(Vp + (size_t)(NT - 1 - ta_) * 64 * vpitch + vgo, (unsigned)__builtin_amdgcn_readfirstlane((int)(lds0 + OFF_V + ((uu) % NVS) * VTB + wid * 1024))); } while (0)
    volatile LAS unsigned* flags = (volatile LAS unsigned*)(lds + OFF_FLAG);
    if (lane == 0) { if (ALIBI) flags[wid] = 0u; flags[8 + wid] = 0u; }
    A2_DMAK(0); A2_DMAV(0); A2_DMAK(1); if (KA == 2) { A2_DMAK(2); A2_DMAK(3); A2_DMAV(1); }
    asm volatile("s_waitcnt vmcnt(0)" ::: "memory"); __syncthreads();
    const LAS unsigned char* kfb = lds + r32 * KROWB + hi * 16;
    const LAS unsigned char* vfb = lds + OFF_V + (4 * hi + ((lane & 15) >> 2)) * 128 + (((lane >> 3) & 1) * 32 + ((lane >> 4) & 1) * 16 + (lane & 3) * 4) * 2;
    const LAS unsigned char* vfc = lds + OFF_V + (4 * hi + ((lane & 15) >> 2)) * 128 + ((((lane >> 3) & 1) ^ 1) * 32 + ((lane >> 4) & 1) * 16 + (lane & 3) * 4) * 2;
    const int qrel = wid * 32 + r32;
    const float boff = (ALIBI && chki == 0) ? cb * (float)(255 - qrel) : 0.f;
    bf16x8 aaug0, aaug1; unsigned cbw = 0u; float cq_ = 0.f;
    if (ALIBI) { const unsigned k0_ = f2bf((float)r32), k1_ = f2bf((float)(r32 + 32));
        const u32x4 a0_ = hi ? (u32x4){0u, 0u, 0u, 0u} : (u32x4){k0_ | (k0_ << 16), 0x3f803f80u, 0x00003f80u, 0u}, a1_ = hi ? (u32x4){0u, 0u, 0u, 0u} : (u32x4){k1_ | (k1_ << 16), 0x3f803f80u, 0x00003f80u, 0u};
        aaug0 = __builtin_bit_cast(bf16x8, a0_); aaug1 = __builtin_bit_cast(bf16x8, a1_);
        const unsigned ch_ = cvtpk(cb, 0.f); cbw = cvtpk(cb, cb - __uint_as_float(ch_ << 16));
        cq_ = (chki != 0) ? cb * -63.f : cb * (float)(192 - qrel); }
#define A2_BAUG(B_, un, mp) do { const float c_ = __builtin_fmaf(cb, (float)(-64 * (un)), cq_ - mhat[mp]); const unsigned h_ = cvtpk(c_, 0.f); const float r1_ = c_ - __uint_as_float(h_ << 16); \
        const unsigned w1_ = cvtpk(c_, r1_); const float r2_ = r1_ - __uint_as_float(w1_ & 0xffff0000u); B_ = __builtin_bit_cast(bf16x8, (u32x4){cbw, w1_, cvtpk(r2_, 0.f), 0u}); } while (0)
    f32x16 SA0, SA1, SB0, SB1;
    bf16x8 kf[NQ]; s16x4 vl[8], vh[8]; u32x4 pw[4];
#define A2_EL(X0, X1, e) ((e) < 16 ? X0[(e) & 15] : X1[(e) & 15])
#define A2_VRD(f) do { const LAS unsigned char* p_ = (((f) & 1) ? vc_ : vb_) + ((f) >> 1) * 2048; vl[f] = vtr(p_); vh[f] = vtr(p_ + 1024); } while (0)
#define A2_KRD1(i, slot, mp) kf[i] = *(const LAS bf16x8*)(kfb + (slot) * KTB + ((i) / NDK) * 32 * KROWB + ((mp) * DQK + ((i) % NDK) * 16) * 2)
#define A2_INIT(X, kb, u, mp) do { if (ALIBI) { const float tb_ = cb * (float)(32 * (kb) - 63 - 64 * (u) + 4 * hi) - mhat[mp] + boff; _Pragma("unroll") for (int r = 0; r < 16; ++r) X[r] = __builtin_fmaf(cb, (float)((r & 3) + 8 * (r >> 2)), tb_); } \
        else { const float nm_ = -mhat[mp]; _Pragma("unroll") for (int r = 0; r < 16; ++r) X[r] = nm_; } } while (0)
#define A2_MASK(X0, X1, u) do { if ((u) < 4) { const int kb_ = 192 - 64 * (u) + 4 * hi; \
        _Pragma("unroll") for (int r = 0; r < 16; ++r) { const int kj = kb_ + (r & 3) + 8 * (r >> 2); if (kj > qrel) X0[r] = NEGM; if (kj + 32 > qrel) X1[r] = NEGM; } } } while (0)
    {
#pragma unroll
        for (int i = 0; i < NQ; ++i) A2_KRD1(i, 0, 0);
        if (!ALIBI) { A2_INIT(SA0, 0, 0, 0); A2_INIT(SA1, 1, 0, 0); }
        else { _Pragma("unroll") for (int r = 0; r < 16; ++r) { SA0[r] = 0.f; SA1[r] = 0.f; } }
#pragma unroll
        for (int d0 = 0; d0 < NDK; ++d0) { SA0 = __builtin_amdgcn_mfma_f32_32x32x16_bf16(kf[d0], qf[0][d0], SA0, 0, 0, 0); SA1 = __builtin_amdgcn_mfma_f32_32x32x16_bf16(kf[NDK + d0], qf[0][d0], SA1, 0, 0, 0); }
        if (ALIBI) { bf16x8 b_; A2_BAUG(b_, 0, 0); SA0 = __builtin_amdgcn_mfma_f32_32x32x16_bf16(aaug0, b_, SA0, 0, 0, 0); SA1 = __builtin_amdgcn_mfma_f32_32x32x16_bf16(aaug1, b_, SA1, 0, 0, 0); }
        A2_MASK(SA0, SA1, 0);
        float rm = 0.f;
        if (chki != 0) { rm = max2f(rowmax32(SA0, SA1), -10000.f); mhat[0] = rm; }
#pragma unroll
        for (int r = 0; r < 16; ++r) { SA0[r] = __builtin_amdgcn_exp2f(SA0[r] - rm); SA1[r] = __builtin_amdgcn_exp2f(SA1[r] - rm); }
#pragma unroll
        for (int i = 0; i < NDK; ++i) { if (NMAP == 2) A2_KRD1(i, 0, 1); else A2_KRD1(i, 1, 0); }
    }
#define A2_STEP(CUR0, CUR1, NXT0, NXT1, mpc, u, mpn, un, sl2, mp2, FIRSTN) do { \
        const LAS unsigned char* vb_ = vfb + ((u) % NVS) * VTB; const LAS unsigned char* vc_ = vfc + ((u) % NVS) * VTB; float sacc = 0.f; \
        bf16x8 baug_; \
        if (ALIBI) A2_BAUG(baug_, un, mpn); else if (chki != 0) { A2_INIT(NXT0, 0, un, mpn); A2_INIT(NXT1, 1, un, mpn); } \
        _Pragma("unroll") for (int g = 0; g < NQ; ++g) { \
            if (g < NDK) A2_KRD1(NDK + g, (un) % NKS, mpn); \
            if (g == NQ - 3) A2_VRD(0); \
            if (g == NQ - 2) A2_VRD(1); \
            A2_SBAR(); \
            if (VAR != 1) { \
                if ((ALIBI || chki == 0) && (g == 0 || g == NDK)) { const f32x16 z_ = {0.f, 0.f, 0.f, 0.f, 0.f, 0.f, 0.f, 0.f, 0.f, 0.f, 0.f, 0.f, 0.f, 0.f, 0.f, 0.f}; \
                    if (g == 0) NXT0 = __builtin_amdgcn_mfma_f32_32x32x16_bf16(kf[g], qf[mpn][g % NDK], z_, 0, 0, 0); else NXT1 = __builtin_amdgcn_mfma_f32_32x32x16_bf16(kf[g], qf[mpn][g % NDK], z_, 0, 0, 0); } \
                else if (g < NDK) NXT0 = __builtin_amdgcn_mfma_f32_32x32x16_bf16(kf[g], qf[mpn][g % NDK], NXT0, 0, 0, 0); else NXT1 = __builtin_amdgcn_mfma_f32_32x32x16_bf16(kf[g], qf[mpn][g % NDK], NXT1, 0, 0, 0); \
                if (ALIBI && g == NDK - 1) NXT0 = __builtin_amdgcn_mfma_f32_32x32x16_bf16(aaug0, baug_, NXT0, 0, 0, 0); \
                if (ALIBI && g == NQ - 1) NXT1 = __builtin_amdgcn_mfma_f32_32x32x16_bf16(aaug1, baug_, NXT1, 0, 0, 0); } \
            else { A2_PIN(kf[g]); } \
            if (VAR != 3) { const int e0_ = (g * 32) / NQ, e1_ = ((g + 1) * 32) / NQ; \
                if (NQ == 4) sacc = fadd_s(sacc, fadd_s(fadd_s(fadd_s(A2_EL(CUR0, CUR1, e0_), A2_EL(CUR0, CUR1, e0_ + 1)), fadd_s(A2_EL(CUR0, CUR1, e0_ + 2), A2_EL(CUR0, CUR1, e0_ + 3))), \
                                                       fadd_s(fadd_s(A2_EL(CUR0, CUR1, e0_ + 4), A2_EL(CUR0, CUR1, e0_ + 5)), fadd_s(A2_EL(CUR0, CUR1, e0_ + 6), A2_EL(CUR0, CUR1, e0_ + 7))))); \
                else { _Pragma("unroll") for (int e = e0_; e < e1_; ++e) sacc += A2_EL(CUR0, CUR1, e); } } \
            A2_PIN(sacc); \
            if (VAR != 3) { _Pragma("unroll") for (int p = (g * 16) / NQ; p < ((g + 1) * 16) / NQ; ++p) pw[p >> 2][p & 3] = cvtpk(A2_EL(CUR0, CUR1, 2 * p), A2_EL(CUR0, CUR1, 2 * p + 1)); } \
            A2_PIN(pw[((g * 16) / NQ) >> 2]); A2_PIN(pw[(((g + 1) * 16) / NQ - 1) >> 2]); \
            A2_HOOKA(g); \
            A2_SBAR(); } \
        lsum[mpc] += sacc; \
        A2_MASK(NXT0, NXT1, un); \
        if (chki != 0) { const float rm_ = rowmax32(NXT0, NXT1); \
          if (FIRSTN) { const float rc_ = max2f(rm_, -10000.f); mhat[mpn] = rc_; _Pragma("unroll") for (int r = 0; r < 16; ++r) { NXT0[r] -= rc_; NXT1[r] -= rc_; } } \
          else if ((un) < NT && __builtin_expect(__any(rm_ > THR), 0)) { const float dl = max2f(rm_, 0.f); mhat[mpn] += dl; \
            _Pragma("unroll") for (int r = 0; r < 16; ++r) { NXT0[r] -= dl; NXT1[r] -= dl; } \
            const float f_ = __builtin_amdgcn_exp2f(-dl); lsum[mpn] *= f_; fres[mpn] = f_; } } \
        A2_SBAR(); \
        _Pragma("unroll") for (int f = 0; f < 8; ++f) { \
            _Pragma("unroll") for (int i = (f * NDK) / 8; i < ((f + 1) * NDK) / 8; ++i) A2_KRD1(i, sl2, mp2); \
            if (f + 2 < 8) A2_VRD(f + 2); \
            A2_SBAR(); \
            { const bf16x8 vf_ = (bf16x8){vl[f][0], vl[f][1], vl[f][2], vl[f][3], vh[f][0], vh[f][1], vh[f][2], vh[f][3]}; \
              if (VAR != 1) O[mpc][f & 1] = __builtin_amdgcn_mfma_f32_32x32x16_bf16(vf_, __builtin_bit_cast(bf16x8, pw[f >> 1]), O[mpc][f & 1], 0, 0, 0); else { bf16x8 t_ = vf_; A2_PIN(t_); A2_PIN(pw[f >> 1]); } } \
            if (VAR != 3) { _Pragma("unroll") for (int e = 4 * f; e < 4 * f + 4; ++e) { if (e < 16) NXT0[e & 15] = __builtin_amdgcn_exp2f(NXT0[e & 15]); else NXT1[e & 15] = __builtin_amdgcn_exp2f(NXT1[e & 15]); } } \
            if (f < 4) A2_PIN(NXT0); else A2_PIN(NXT1); \
            A2_HOOKB(f); \
            A2_SBAR(); } \
        if (chki != 0) _Pragma("unroll") for (int mp_ = 0; mp_ < NMAP; ++mp_) if (__any(fres[mp_] != 1.f)) { \
            _Pragma("unroll") for (int db = 0; db < 2; ++db) _Pragma("unroll") for (int r = 0; r < 16; ++r) O[mp_][db][r] *= fres[mp_]; fres[mp_] = 1.f; } \
    } while (0)
#define A2_ENDTILE(u) do { \
        if (ALIBI && (u) == 3) { float d_; \
            if (chki != 0) { d_ = qn[0] - mhat[0]; if (NMAP == 2) d_ = max2f(d_, qn[NMAP - 1] - mhat[NMAP - 1]); } \
            else { d_ = qn[0] - __builtin_amdgcn_logf(xhalf_sum(lsum[0])); if (NMAP == 2) d_ = max2f(d_, qn[NMAP - 1] - __builtin_amdgcn_logf(xhalf_sum(lsum[NMAP - 1]))); d_ += boff; } \
            _Pragma("unroll") for (int o_ = 1; o_ < 64; o_ <<= 1) d_ = max2f(d_, __shfl_xor(d_, o_)); \
            if (lane == 0) flags[wid] = __float_as_uint(d_); } \
        if (VAR != 2) { asm volatile("s_waitcnt vmcnt(0)" ::: "memory"); __syncthreads(); } \
        if (ALIBI && (u) == 3) { const u32x4 f0 = *(const LAS u32x4*)(lds + OFF_FLAG), f1 = *(const LAS u32x4*)(lds + OFF_FLAG + 16); \
            const float D_ = max2f(max3f(__uint_as_float(f0.x), __uint_as_float(f0.y), __uint_as_float(f0.z)), max3f(__uint_as_float(f0.w), __uint_as_float(f1.x), __uint_as_float(f1.y))); \
            const float D2_ = max3f(D_, __uint_as_float(f1.z), __uint_as_float(f1.w)); \
            const float nf_ = floorf((SKIP_THR + D2_) / (64.f * cb)) + 1.f; int n_ = NT; if (nf_ < (float)NT) { n_ = (int)nf_; n_ = n_ < 4 ? 4 : n_; }     \
            nt_eff = __builtin_amdgcn_readfirstlane(n_); } \
    } while (0)
    int nt_eff = NT;
    if (NMAP == 2) {
        for (int u = 0; u < nt_eff; ++u) {
#define A2_HOOKA(g)
#define A2_HOOKB(f) do { if ((f) == 1) A2_DMAK1(u + 2, 0); if ((f) == 2) A2_DMAK1(u + 2, 1); if ((f) == 4) A2_DMAV1(u + 1); } while (0)
            A2_STEP(SA0, SA1, SB0, SB1, 0, u, NMAP - 1, u, (u + 1) % 3, 0, (u == 0));
#undef A2_HOOKB
#define A2_HOOKB(f)
            A2_STEP(SB0, SB1, SA0, SA1, NMAP - 1, u, 0, u + 1, (u + 1) % 3, NMAP - 1, false);
#undef A2_HOOKA
#undef A2_HOOKB
            A2_ENDTILE(u);
        }
    } else {
        for (int u = 0; u < NT; u += 2) {
#define A2_HOOKA(g) do { if ((g) == 1) A2_DMAK1(u + 4, 0); if ((g) == 2) A2_DMAK1(u + 4, 1); if ((g) == 4) A2_DMAK1(u + 5, 0); if ((g) == 5) A2_DMAK1(u + 5, 1); if ((g) == 7) A2_DMAV1(u + 2); if ((g) == 9) A2_DMAV1(u + 3); } while (0)
#define A2_HOOKB(f)
            A2_STEP(SA0, SA1, SB0, SB1, 0, u, 0, u + 1, (u + 2) % NKS, 0, false);
#undef A2_HOOKA
#define A2_HOOKA(g)
            A2_STEP(SB0, SB1, SA0, SA1, 0, u + 1, 0, u + 2, (u + 3) % NKS, 0, false);
#undef A2_HOOKA
#undef A2_HOOKB
            A2_ENDTILE(u + 1);
        }
    }
#undef A2_DMAK
#undef A2_DMAV
#undef A2_DMAK1
#undef A2_DMAV1
#undef A2_EL
#undef A2_KRD1
#undef A2_VRD
#undef A2_INIT
#undef A2_BAUG
#undef A2_MASK
#undef A2_STEP
#undef A2_ENDTILE
    float ltot[NMAP];
#pragma unroll
    for (int mp = 0; mp < NMAP; ++mp) ltot[mp] = xhalf_sum(lsum[mp]);
    epi(O, ltot, wid * 32 + r32, r32, hi, lds + wid * 4608);
    if (CHK) return false;
    unsigned mxb = 0u;
#pragma unroll
    for (int mp = 0; mp < NMAP; ++mp) { const unsigned lb = __float_as_uint(ltot[mp]) & 0x7fffffffu; mxb = mxb > lb ? mxb : lb; if (lb < 0x21800000u) mxb = 0x7f800000u;
#pragma unroll
        for (int db = 0; db < 2; ++db)
#pragma unroll
            for (int r = 0; r < 16; ++r) { const unsigned ob = __float_as_uint(O[mp][db][r]) & 0x7fffffffu; mxb = mxb > ob ? mxb : ob; } }
    if (__any(mxb >= 0x7f800000u) && lane == 0) flags[8 + wid] = 1u;
    __syncthreads();
    const u32x4 g0 = *(const LAS u32x4*)(lds + OFF_FLAG + 32), g1 = *(const LAS u32x4*)(lds + OFF_FLAG + 48);
    return (g0.x | g0.y | g0.z | g0.w | g1.x | g1.y | g1.z | g1.w) != 0u;
}
}

struct Args { const void* in[30]; float* out; unsigned char* ws; int ph_lo, ph_hi; int reps, pad_; };
constexpr int N_PHASES = 13;
#ifndef MK_N_LAUNCHES
#define MK_N_LAUNCHES 1
#endif
#ifndef FORCE_RETRY
#define FORCE_RETRY 0
#endif
#ifndef CONV_WG
#define CONV_WG 32
#endif
#ifndef PROBE_VAR
#define PROBE_VAR -1
#endif
#ifndef PROBE_PH
#define PROBE_PH 0
#endif
#ifndef PROBE_REP_MLA
#define PROBE_REP_MLA 1
#endif
#ifndef PROBE_REP_DIFF
#define PROBE_REP_DIFF 1
#endif

struct P0Item { const float* W; const float* gain; unsigned char* WT; int K, N, row_off, goff, mode, f8, k0, n0; float scale; };
__device__ __forceinline__ void p0_item_load(const P0Item& d, int lane, f32x4 (&v)[8], float (&g)[8]) {
    const int lr = lane >> 4, lc = 4 * (lane & 15); const bool cok = (d.n0 + lc) < d.N;
#pragma unroll
    for (int i = 0; i < 8; ++i) { const int k = d.k0 + 4 * i + lr; v[i] = cok ? __builtin_nontemporal_load((const f32x4*)(d.W + (size_t)k * d.N + d.n0 + lc)) : (f32x4){0.f, 0.f, 0.f, 0.f};
        g[i] = (d.gain && k >= d.goff) ? d.gain[k - d.goff] : 1.f; }
}
__device__ __forceinline__ void p0_item_finish(const P0Item& d, int lane, const f32x4 (&v)[8], const float (&g)[8], LAS float* scr) {
    const int lr = lane >> 4, lc = 4 * (lane & 15);
#pragma unroll
    for (int i = 0; i < 8; ++i) { const int kk = 4 * i + lr; const float gs = g[i] * d.scale;
        LAS float* p = scr + kk * 65 + lc; p[0] = v[i][0] * gs; p[1] = v[i][1] * gs; p[2] = v[i][2] * gs; p[3] = v[i][3] * gs; }
    LDS_WAIT(); asm volatile("" ::: "memory");
    const int c = lane & 3;
#pragma unroll
    for (int j = 0; j < 4; ++j) { const int n = (lane >> 2) + 16 * j; const LAS float* sp = scr + (8 * c) * 65 + n;
        const int col = d.n0 + n; int row = col;
        if (d.mode == 1) row = 2 * (col & ~15) + (col & 15);
        if (d.mode == 2) row = 2 * (col & ~15) + 16 + (col & 15);
        if (d.f8) { unsigned w0 = 0, w1 = 0;
            w0 = __builtin_amdgcn_cvt_pk_fp8_f32(sp[0 * 65], sp[1 * 65], w0, false); w0 = __builtin_amdgcn_cvt_pk_fp8_f32(sp[2 * 65], sp[3 * 65], w0, true);
            w1 = __builtin_amdgcn_cvt_pk_fp8_f32(sp[4 * 65], sp[5 * 65], w1, false); w1 = __builtin_amdgcn_cvt_pk_fp8_f32(sp[6 * 65], sp[7 * 65], w1, true);
            if (col < d.N) *(u32x2*)(d.WT + (size_t)(d.row_off + row) * d.K + d.k0 + 8 * c) = (u32x2){w0, w1}; }
        else { u32x4 o; o.x = cvtpk(sp[0 * 65], sp[1 * 65]); o.y = cvtpk(sp[2 * 65], sp[3 * 65]); o.z = cvtpk(sp[4 * 65], sp[5 * 65]); o.w = cvtpk(sp[6 * 65], sp[7 * 65]);
            if (col < d.N) *(u32x4*)(d.WT + ((size_t)(d.row_off + row) * d.K + d.k0 + 8 * c) * 2) = o; } }
    LDS_WAIT(); asm volatile("" ::: "memory");
}
template <int NR> __device__ __forceinline__ void rms_rows_load(const float* xrow, int lane, f32x4 (&v)[NR][4]) {
#pragma unroll
    for (int r = 0; r < NR; ++r)
#pragma unroll
        for (int j = 0; j < 4; ++j) v[r][j] = __builtin_nontemporal_load((const f32x4*)(xrow + (size_t)r * DM) + lane + 64 * j);
}
template <int NR> __device__ __forceinline__ void rms_rows_finish(const f32x4 (&v)[NR][4], const float* gain, bf16* orow, int lane, float* inv_rs = nullptr) {
    float s[NR];
#pragma unroll
    for (int r = 0; r < NR; ++r) { s[r] = 0.f;
#pragma unroll
        for (int j = 0; j < 4; ++j) s[r] += pg8::sq4(v[r][j]); }
#pragma unroll
    for (int o = 1; o < 64; o <<= 1)
#pragma unroll
        for (int r = 0; r < NR; ++r) s[r] += __shfl_xor(s[r], o);
    const f32x4* gr = (const f32x4*)gain + lane;
    if (inv_rs && lane == 0) {
#pragma unroll
        for (int r = 0; r < NR; ++r) inv_rs[r] = 1.f / __builtin_amdgcn_rsqf(s[r] * (1.f / DM) + EPS); }
#pragma unroll
    for (int j = 0; j < 4; ++j) { const f32x4 g = gain ? gr[64 * j] : (f32x4){1.f, 1.f, 1.f, 1.f};
#pragma unroll
        for (int r = 0; r < NR; ++r) { const float rs = __builtin_amdgcn_rsqf(s[r] * (1.f / DM) + EPS); const f32x4 y = v[r][j] * rs * g; u32x2 w; w.x = cvtpk(y[0], y[1]); w.y = cvtpk(y[2], y[3]); ((u32x2*)(orow + (size_t)r * DM) + lane)[64 * j] = w; } }
}
__device__ __forceinline__ float pk_sq4(float a, float b, float c, float d) { return (a * a + b * b) + (c * c + d * d); }

constexpr float MIX_SC = 32.f;
__device__ __forceinline__ unsigned pk8x4(f32x4 v) { unsigned t = 0; t = __builtin_amdgcn_cvt_pk_fp8_f32(v[0], v[1], t, false); t = __builtin_amdgcn_cvt_pk_fp8_f32(v[2], v[3], t, true); return t; }
__device__ __forceinline__ void st_row32(unsigned char* p, const unsigned (&w)[4]) {
    const auto p0 = __builtin_amdgcn_permlane32_swap(w[0], w[1], false, false), p1 = __builtin_amdgcn_permlane32_swap(w[2], w[3], false, false);
    const auto q0 = __builtin_amdgcn_permlane32_swap(p0[0], p1[0], false, false), q1 = __builtin_amdgcn_permlane32_swap(p0[1], p1[1], false, false);
    *(u32x4*)p = (u32x4){q0[0], q1[0], q0[1], q1[1]};
}
struct EpiDiff {
    unsigned char* out; float lam; const float* gain;
    __device__ __forceinline__ void operator()(const f32x16 (&O)[2][2], const float (&l)[2], int qrow, int r32, int hi, LAS unsigned char*) const {
        const float i1 = 1.f / l[0], i2 = lam / l[1]; float o[2][16]; float ss = 0.f;
#pragma unroll
        for (int db = 0; db < 2; ++db)
#pragma unroll
            for (int r = 0; r < 16; ++r) { const float v = O[0][db][r] * i1 - O[1][db][r] * i2; o[db][r] = v; ss += v * v; }
        ss += __shfl_xor(ss, 32);
        const float rs = __builtin_amdgcn_rsqf(ss * (1.f / 64.f) + EPS) * ((1.f - LAMBDA_INIT) * MIX_SC);
        unsigned char* rowp = out + (size_t)qrow * DM + 16 * hi;
#pragma unroll
        for (int db = 0; db < 2; ++db) { unsigned w[4];
#pragma unroll
            for (int rq = 0; rq < 4; ++rq) { const int d = 32 * db + 8 * rq + 4 * hi; const f32x4 g = *(const f32x4*)(gain + d);
                w[rq] = pk8x4((f32x4){o[db][4 * rq] * g[0], o[db][4 * rq + 1] * g[1], o[db][4 * rq + 2] * g[2], o[db][4 * rq + 3] * g[3]} * rs); }
            st_row32(rowp + 32 * db, w); }
    }
};
struct EpiMla {
    unsigned char* out; float* ssq;
    __device__ __forceinline__ void operator()(const f32x16 (&O)[1][2], const float (&l)[1], int qrow, int r32, int hi, LAS unsigned char*) const {
        const float il = 1.f / l[0]; float ss = 0.f; unsigned char* rowp = out + (size_t)qrow * DM + 16 * hi;
#pragma unroll
        for (int db = 0; db < 2; ++db) { unsigned w[4];
#pragma unroll
            for (int rq = 0; rq < 4; ++rq) {
                const f32x4 v = (f32x4){O[0][db][4 * rq], O[0][db][4 * rq + 1], O[0][db][4 * rq + 2], O[0][db][4 * rq + 3]} * il; ss += pg8::sq4(v);
                w[rq] = pk8x4(v * MIX_SC); }
            st_row32(rowp + 32 * db, w); }
        ss += __shfl_xor(ss, 32);
        if (hi == 0) ssq[(size_t)qrow * 8] = ss;
    }
};
struct EpiCross {
    unsigned char* out;
    __device__ __forceinline__ void operator()(const f32x16 (&O)[1][4], const float (&l)[1], int qrow, int r32, int hi, LAS unsigned char*) const {
        const float il = 8.f / l[0]; unsigned char* rowp = out + (size_t)qrow * 512 + 16 * hi;
#pragma unroll
        for (int db = 0; db < 4; ++db) { unsigned w[4];
#pragma unroll
            for (int rq = 0; rq < 4; ++rq) { unsigned t = 0;
                t = __builtin_amdgcn_cvt_pk_fp8_f32(O[0][db][4 * rq] * il, O[0][db][4 * rq + 1] * il, t, false); t = __builtin_amdgcn_cvt_pk_fp8_f32(O[0][db][4 * rq + 2] * il, O[0][db][4 * rq + 3] * il, t, true); w[rq] = t; }
            const auto p0 = __builtin_amdgcn_permlane32_swap(w[0], w[1], false, false), p1 = __builtin_amdgcn_permlane32_swap(w[2], w[3], false, false);
            const auto q0 = __builtin_amdgcn_permlane32_swap(p0[0], p1[0], false, false), q1 = __builtin_amdgcn_permlane32_swap(p0[1], p1[1], false, false);
            *(u32x4*)(rowp + 32 * db) = (u32x4){q0[0], q1[0], q0[1], q1[1]}; }
    }
};

__global__ void __launch_bounds__(NWAVES * 64, 2) mega_fwd(Args args) {
    extern __shared__ __attribute__((aligned(16))) unsigned char lds_raw[];
    LAS unsigned char* lds = (LAS unsigned char*)lds_raw;
    volatile LAS unsigned* MISC = (volatile LAS unsigned*)(lds + MISC_OFF);
    LAS int* TP = (LAS int*)(lds + TP_OFF);
    const int tid = threadIdx.x, lane = tid & 63, wave = __builtin_amdgcn_readfirstlane(tid >> 6);
    const int G = gridDim.x; const int bx = blockIdx.x; const int vcu = (G % 8 == 0) ? (bx % 8) * (G / 8) + bx / 8 : bx;
    typedef const void* cvp_t;
    __attribute__((address_space(4))) const unsigned char* kp = (__attribute__((address_space(4))) const unsigned char*)__builtin_amdgcn_kernarg_segment_ptr();
    asm volatile("" : "+s"(kp));
#define KARG(i) (*(const __attribute__((address_space(4))) cvp_t*)(kp + 8 * (i)))
#define ws ((unsigned char*)KARG(31))
#define ctl ((unsigned*)(ws + WS_CTL))
#define xin ((const float*)KARG(0))
#define mem ((const float*)KARG(1))
#define positions ((const int*)KARG(2))
#define norm_mix_g ((const float*)KARG(3))
#define w_in ((const float*)KARG(4))
#define lq1 ((const float*)KARG(5))
#define lk1 ((const float*)KARG(6))
#define lq2 ((const float*)KARG(7))
#define lk2 ((const float*)KARG(8))
#define diff_out_g ((const float*)KARG(9))
#define mla_q_norm_g ((const float*)KARG(10))
#define w_mla_uq ((const float*)KARG(11))
#define mla_kv_norm_g ((const float*)KARG(12))
#define w_mla_ukv ((const float*)KARG(13))
#define mla_out_g ((const float*)KARG(14))
#define w_out ((const float*)KARG(15))
#define norm_cross_g ((const float*)KARG(16))
#define norm_mem_g ((const float*)KARG(17))
#define w_mem_q ((const float*)KARG(18))
#define w_mem_kv ((const float*)KARG(19))
#define w_mem_o ((const float*)KARG(20))
#define norm_ffn_g ((const float*)KARG(21))
#define w_group_router ((const float*)KARG(22))
#define b_group_router ((const float*)KARG(23))
#define w_expert_router ((const float*)KARG(24))
#define b_expert_router ((const float*)KARG(25))
#define w_expert_gate ((const float*)KARG(26))
#define w_expert_up ((const float*)KARG(27))
#define w_expert_down ((const float*)KARG(28))
#define norm_final_g ((const float*)KARG(29))
#define W_IN ((bf16*)(ws + WS_WIN))
#define W_UQ ((bf16*)(ws + WS_WUQ))
#define W_UKV ((bf16*)(ws + WS_WUKV))
#define W_OUT ((bf16*)(ws + WS_WOUT))
#define W_MQ ((bf16*)(ws + WS_WMQ))
#define W_MKV ((bf16*)(ws + WS_WMKV))
#define W_MO ((bf16*)(ws + WS_WMO))
#define W_R ((bf16*)(ws + WS_WR))
#define W_GU ((bf16*)(ws + WS_WGU))
#define W_DN ((bf16*)(ws + WS_WDN))
#define RCOS ((float*)(ws + WS_ROPE))
#define SSQM ((float*)(ws + WS_SSQM))
#define SSQ1 ((float*)(ws + WS_SSQ1))
#define SSQ2 ((float*)(ws + WS_SSQ2))
#define SSQQ ((float*)(ws + WS_SSQQ))
#define SSQKV ((float*)(ws + WS_SSQKV))
#define KC ((bf16*)(ws + WS_KC))
#define VC ((bf16*)(ws + WS_VC))
#define MEMN ((bf16*)(ws + WS_MEMN))
#define WTS ((float*)(ws + WS_WT))
#define RS2 ((float*)(ws + WS_RS2))
#define MISCF ((float*)(ws + WS_MISC))
#define LIST ((int*)(ws + WS_LIST))
#define XN ((bf16*)(ws + WS_A0))
#define MIX ((bf16*)(ws + WS_MIX))
#define HB ((bf16*)(ws + WS_A0))
#define QD ((bf16*)(ws + WS_QD))
#define KD ((bf16*)(ws + WS_KD))
#define VD ((bf16*)(ws + WS_VD))
#define X1B ((bf16*)(ws + WS_X1B))
#define QC ((bf16*)(ws + WS_QC))
#define CQ ((bf16*)(ws + WS_CQ))
#define CKV ((bf16*)(ws + WS_CKV))
#define QM ((bf16*)(ws + WS_QM))
#define KM ((bf16*)(ws + WS_KM))
#define VM ((bf16*)(ws + WS_VM))
#define X2B ((bf16*)(ws + WS_X2B))
#define OC ((bf16*)(ws + WS_OC))
#define YB ((bf16*)(ws + WS_Y))
#define RSIN (RCOS + (size_t)T * 16)
#define CNT (ctl + CW_CNT)

    for (int u = tid; u < (LDS_BYTES - LDSCTL_OFF) / 4; u += NWAVES * 64) ((LAS unsigned*)(lds + LDSCTL_OFF))[u] = 0u;
    __syncthreads();
    XcdBarrier bar; bar.bar = ctl + CW_BAR; bar.x = 0; bar.st = nullptr;
    if (MK_N_LAUNCHES == 1) bar = xcd_barrier_post(ctl + CW_BAR, MISC);
    const int lo = *(const __attribute__((address_space(4))) int*)(kp + 256), hi_ph = *(const __attribute__((address_space(4))) int*)(kp + 260);
#ifndef PH_MASK
#define PH_MASK 0xFFFF
#endif
#define IN(k) (((PH_MASK >> (k)) & 1) && lo <= (k) && (k) < hi_ph)
#define SEAM(k) do { if (IN(k) && IN((k) + 1)) xcd_barrier(bar); } while (0)
    const int gw = vcu * NWAVES + wave, NGW = G * NWAVES;

    constexpr int I_IN = 32 * 31, I_UQ = 8 * 12, I_UKV = 4 * 16, I_OUT = 32 * 16, I_MQ = 32 * 8, I_MKV = 32 * 16, I_MO = 16 * 16, I_G = 32 * 4, I_D = 8 * 16;
    constexpr int C0 = NEXP * I_G, C1 = C0 + NEXP * I_G, C2 = C1 + NEXP * I_D, C3 = C2 + I_OUT, C4 = C3 + I_MQ, C5 = C4 + I_MKV, C6 = C5 + I_MO, C7 = C6 + I_UQ, C8 = C7 + I_UKV, C9 = C8 + I_IN;
    _Pragma("unroll") for (int rep_ = 0; rep_ < (((PROBE_PH >> 0) & 1) ? 2 : 1); ++rep_) if (IN(0)) {
        LAS float* scr = (LAS float*)(lds + wave * 16384);
#define P0_DECODE(idx, d) do { int r_ = (idx); int it_; \
            if (r_ < C0) { const int e = r_ / I_G; it_ = r_ % I_G; d = P0Item{w_expert_gate + (size_t)e * DM * EFF, norm_ffn_g, (unsigned char*)W_GU, DM, EFF, e * 512, 0, 1, 1, 0, 0, 32.f}; } \
            else if (r_ < C1) { r_ -= C0; const int e = r_ / I_G; it_ = r_ % I_G; d = P0Item{w_expert_up + (size_t)e * DM * EFF, norm_ffn_g, (unsigned char*)W_GU, DM, EFF, e * 512, 0, 2, 1, 0, 0, 32.f}; } \
            else if (r_ < C2) { r_ -= C1; const int e = r_ / I_D; it_ = r_ % I_D; d = P0Item{w_expert_down + (size_t)e * EFF * DM, nullptr, (unsigned char*)W_DN, EFF, DM, e * 1024, 0, 0, 1, 0, 0, 16.f}; } \
            else if (r_ < C3) { it_ = r_ - C2; d = P0Item{w_out, mla_out_g, (unsigned char*)W_OUT, DM, DM, 0, 512, 0, 1, 0, 0, 16.f}; } \
            else if (r_ < C4) { it_ = r_ - C3; d = P0Item{w_mem_q, norm_cross_g, (unsigned char*)W_MQ, DM, 512, 0, 0, 0, 0, 0, 0, 1.f}; } \
            else if (r_ < C5) { it_ = r_ - C4; d = P0Item{w_mem_kv, nullptr, (unsigned char*)W_MKV, DM, 1024, 0, 0, 0, 0, 0, 0, 1.f}; } \
            else if (r_ < C6) { it_ = r_ - C5; d = P0Item{w_mem_o, nullptr, (unsigned char*)W_MO, 512, 1024, 0, 0, 0, 1, 0, 0, 16.f}; } \
            else if (r_ < C7) { it_ = r_ - C6; d = P0Item{w_mla_uq, mla_q_norm_g, (unsigned char*)W_UQ, 256, 768, 0, 0, 0, 0, 0, 0, 1.f}; } \
            else if (r_ < C8) { it_ = r_ - C7; d = P0Item{w_mla_ukv, mla_kv_norm_g, (unsigned char*)W_UKV, 128, 1024, 0, 0, 0, 0, 0, 0, 1.f}; } \
            else { it_ = r_ - C8; d = P0Item{w_in, norm_mix_g, (unsigned char*)W_IN, DM, INW, 0, 0, 0, 0, 0, 0, 1.f}; } \
            { const int nblk_ = (d.N + 63) / 64; d.k0 = 32 * (it_ / nblk_); d.n0 = 64 * (it_ % nblk_); } } while (0)
        {
            P0Item dc, dn; f32x4 va[8], vb[8]; float ga[8], gb[8];
            int idx = C2 + gw;
            if (idx < C9) { P0_DECODE(idx, dc); p0_item_load(dc, lane, va, ga); }
            while (idx < C9) {
                const int nx = idx + NGW; const bool hn = nx < C9;
                if (hn) { P0_DECODE(nx, dn); p0_item_load(dn, lane, vb, gb); }
                p0_item_finish(dc, lane, va, ga, scr);
                if (hn) { dc = dn;
#pragma unroll
                    for (int i = 0; i < 8; ++i) { va[i] = vb[i]; ga[i] = gb[i]; } }
                idx = nx;
            }
        }
        {
            f32x4 xa[4][4], xb[4][4]; int m = gw * 4;
            if (m < T) rms_rows_load<4>(xin + (size_t)m * DM, lane, xa);
            while (m < T) {
                const int mn = m + NGW * 4; const bool hn = mn < T;
                if (hn) rms_rows_load<4>(xin + (size_t)mn * DM, lane, xb);
                rms_rows_finish<4>(xa, nullptr, XN + (size_t)m * DM, lane, (float*)(ws + WS_RS0) + m);
                if (hn) {
#pragma unroll
                    for (int r = 0; r < 4; ++r)
#pragma unroll
                        for (int j = 0; j < 4; ++j) xa[r][j] = xb[r][j]; }
                m = mn;
            }
        }
        for (int m = gw; m < NB * NMEM; m += NGW) { f32x4 xm[1][4]; rms_rows_load<1>(mem + (size_t)m * DM, lane, xm); rms_rows_finish<1>(xm, norm_mem_g, MEMN + (size_t)m * DM, lane); }
        for (int i = vcu * 512 + tid; i < T * 16; i += G * 512) {
            const int tk = i >> 4, fi = i & 15;
            const float invf = (float)exp2(-(double)fi * (13.287712379549449 / 16.0));
            const float ang = (float)positions[tk] * invf;
            const double xd = (double)ang; const double kq = rint(xd * 0.6366197723675814);
            double rr = fma(-kq, 1.5707963267948966, xd); rr = fma(-kq, 6.123233995736766e-17, rr);
            const double r2 = rr * rr;
            const double sn = rr * (1.0 + r2 * (-1.0 / 6 + r2 * (1.0 / 120 + r2 * (-1.0 / 5040 + r2 * (1.0 / 362880 + r2 * (-1.0 / 39916800))))));
            const double cs = 1.0 + r2 * (-0.5 + r2 * (1.0 / 24 + r2 * (-1.0 / 720 + r2 * (1.0 / 40320 + r2 * (-1.0 / 3628800 + r2 * (1.0 / 479001600))))));
            const int q = ((int)kq) & 3;
            const double c = (q == 0) ? cs : (q == 1) ? -sn : (q == 2) ? -cs : sn;
            const double s = (q == 0) ? sn : (q == 1) ? cs : (q == 2) ? -sn : -cs;
            RCOS[i] = (float)c; RSIN[i] = (float)s;
        }
        for (int i = vcu * 512 + tid; i < 36 * DM; i += G * 512) {
            const int n = i / DM, k = i % DM;
            const float w = (n < 32 ? w_expert_router[(size_t)k * 32 + n] : w_group_router[(size_t)k * 4 + (n - 32)]) * norm_ffn_g[k];
            const unsigned h = f2bf(w); const float res = w - __uint_as_float(h << 16);
            W_R[i] = (bf16)h; W_R[36 * DM + i] = (bf16)f2bf(res);
        }
        if (bx == 0 && wave == 0) {
            float a = (lane < 32) ? lq1[lane] * lk1[lane] : 0.f, b = (lane < 32) ? lq2[lane] * lk2[lane] : 0.f;
            a = wave_sum(a); b = wave_sum(b);
            if (lane == 0) MISCF[0] = expf(a) - expf(b) + LAMBDA_INIT;
        }
    }
    SEAM(0);
    _Pragma("unroll") for (int rep_ = 0; rep_ < (((PROBE_PH >> 1) & 1) ? 2 : 1); ++rep_) if (IN(1)) {
        { pg8::InProjOrder S{bx, (const char*)W_IN, DM};
          pg8::EpiInProj E{QD, KD, VD, CQ, CKV, KM, SSQQ, SSQKV, RCOS, RSIN, ctl + CW_KMAX};
          pg8::gemm_phase<pg8::EpiInProj, pg8::InProjOrder, true>(lds, (const char*)XN, DM, DM, DM, S, E); }
        asm volatile("s_waitcnt vmcnt(0)" ::: "memory"); __syncthreads();
        if (bx < 128) { pg8::RowUnits S{bx & 127, 3, (const char*)W_UQ, 256, 2}; pg8::EpiUpQ E{QM, SSQQ, RCOS, RSIN};
            pg8::gemm_phase<pg8::EpiUpQ, pg8::RowUnits, true>(lds, (const char*)CQ, 256, 256, 256, S, E); }
        else if (bx < 256) { pg8::RowUnits S{bx & 127, 4, (const char*)W_UKV, 128, 2}; pg8::EpiUpKV E{KM, VM, SSQKV};
            pg8::gemm_phase<pg8::EpiUpKV, pg8::RowUnits, true>(lds, (const char*)CKV, 128, 128, 128, S, E); }
    }
    if (IN(2) && bx == G - 1) {
        LAS int* hist = (LAS int*)lds; int* UTAB = (int*)(ws + WS_UTAB);
        for (int ty = 0; ty < 2; ++ty) {
            __syncthreads();
            for (int i = tid; i < 136; i += 512) hist[i] = 0;
            __syncthreads();
            int cost[2];
#pragma unroll
            for (int k = 0; k < 2; ++k) { const int id = tid + 512 * k, qb = id & 31, h = (id >> 5) & 7; int tiles = 4 * (qb + 1);
                if (ty == 0) { const int est = 5 + ((52 << h) + 63) / 64; tiles = tiles < est ? tiles : est; }
                cost[k] = tiles; atomicAdd((int*)&hist[128 - tiles], 1); }
            __syncthreads();
            if (wave == 0) {
                const int a = hist[lane], b = hist[64 + lane]; int sa = a, sb = b;
#pragma unroll
                for (int o = 1; o < 64; o <<= 1) { const int ta = __shfl_up(sa, o), tb = __shfl_up(sb, o); if (lane >= o) { sa += ta; sb += tb; } }
                const int tota = __shfl(sa, 63), totb = __shfl(sb, 63);
                hist[lane] = sa - a; hist[64 + lane] = tota + sb - b; if (lane == 0) hist[128] = tota + totb; }
            __syncthreads();
#pragma unroll
            for (int k = 0; k < 2; ++k) { const int pos = atomicAdd((int*)&hist[128 - cost[k]], 1); UTAB[ty * 1024 + pos] = tid + 512 * k; }
        }
        __syncthreads();
    }
    SEAM(2);
    if (IN(3)) {
        const float lam = MISCF[0];
        { pg8::DenseOrder S; S.init(NB * NMEM, 1024, 16, bx, DM, W_MKV, DM); pg8::EpiMemKV E{KC, VC};
          if (bx < 16) pg8::gemm_phase<pg8::EpiMemKV, pg8::DenseOrder, true>(lds, (const char*)MEMN, DM, DM, DM, S, E); }
        if (bx >= 16 && bx < 16 + CONV_WG) {
            int tid_c = threadIdx.x; asm volatile("" : "+v"(tid_c));
            const int lane_c = tid_c & 63, wave_c = __builtin_amdgcn_readfirstlane(tid_c >> 6);
            LAS float* scr = (LAS float*)(lds + wave_c * 16384);
            P0Item d0, d1, d2; f32x4 v0[8], v1[8], v2[8]; float g0[8], g1[8], g2[8];
            constexpr int CS = CONV_WG * NWAVES;
            int idx = (bx - 16) * NWAVES + wave_c;
            if (idx < C2) { P0_DECODE(idx, d0); p0_item_load(d0, lane_c, v0, g0); }
            if (idx + CS < C2) { P0_DECODE(idx + CS, d1); p0_item_load(d1, lane_c, v1, g1); }
            while (idx < C2) {
                if (idx + 2 * CS < C2) { P0_DECODE(idx + 2 * CS, d2); p0_item_load(d2, lane_c, v2, g2); }
                p0_item_finish(d0, lane_c, v0, g0, scr);
                idx += CS; if (idx >= C2) break;
                if (idx + 2 * CS < C2) { P0_DECODE(idx + 2 * CS, d0); p0_item_load(d0, lane_c, v0, g0); }
                p0_item_finish(d1, lane_c, v1, g1, scr);
                idx += CS; if (idx >= C2) break;
                if (idx + 2 * CS < C2) { P0_DECODE(idx + 2 * CS, d1); p0_item_load(d1, lane_c, v1, g1); }
                p0_item_finish(d2, lane_c, v2, g2, scr);
                idx += CS;
            }
            __syncthreads();
        }
        const int* UTAB = (const int*)(ws + WS_UTAB);
        volatile LAS int* qslot = (volatile LAS int*)(lds + TP_OFF + 160);
        int* redo = (int*)(ws + WS_REDO) + (size_t)bx * 2048; int nredo_d = 0, nredo_m = 0;
        LAS int* utl = (LAS int*)(lds + RING_BYTES - 8192);
        __syncthreads();
        for (int i = tid; i < 2048; i += NWAVES * 64) utl[i] = UTAB[i];
        __syncthreads();
#ifndef ATT_NO_DIFF
        {
            if (tid == 0) qslot[0] = (int)atomicAdd(ctl + CW_QHEAD, 1u);
            __syncthreads();
            int nxt = 0;
            for (;;) {
                const int qi = qslot[0];
                __syncthreads();
                if (qi >= 1024) break;
                if (tid == 0) nxt = (int)atomicAdd(ctl + CW_QHEAD, 1u);
                const int id = utl[qi], qb = id & 31, bh = id >> 5, b = bh >> 3, h = bh & 7;
                const size_t rowb = (size_t)b * SEQ; const int q0 = qb * 256; const int NT = (q0 + 256) / 64;
                const float km0 = sqrtf(__uint_as_float(__hip_atomic_load(ctl + CW_KMAX + b * 16 + h * 2, __ATOMIC_RELAXED, __HIP_MEMORY_SCOPE_AGENT))) * 1.02f;
                const float km1 = sqrtf(__uint_as_float(__hip_atomic_load(ctl + CW_KMAX + b * 16 + h * 2 + 1, __ATOMIC_RELAXED, __HIP_MEMORY_SCOPE_AGENT))) * 1.02f;
                EpiDiff E{(unsigned char*)MIX + (rowb + q0) * DM + h * 64, lam, diff_out_g};
                const bool bad = __builtin_amdgcn_readfirstlane((int)att2::unit<32, 2, true, 512, 512, 512, EpiDiff, 0, false>(lds, QD + (rowb + q0) * 512 + h * 64, KD + rowb * 512 + h * 64, VD + rowb * 512 + h * 64, NT, q0, LOG2E * __builtin_amdgcn_exp2f(-(float)(h + 1)), km0, km1, E)) != 0 || (FORCE_RETRY && (id & 7) == 3);
                if (bad) { if (tid == 0) __hip_atomic_store(redo + nredo_d, id, __ATOMIC_RELAXED, __HIP_MEMORY_SCOPE_AGENT); ++nredo_d; }
                if (tid == 0) qslot[0] = nxt;
                __syncthreads();
            }
        }
#endif
#ifndef ATT_NO_MLA
        {
            if (tid == 0) qslot[0] = (int)atomicAdd(ctl + CW_QHEAD + 64, 1u);
            __syncthreads();
            int nxt = 0;
            for (;;) {
                const int qi = qslot[0];
                __syncthreads();
                if (qi >= 1024) break;
                if (tid == 0) nxt = (int)atomicAdd(ctl + CW_QHEAD + 64, 1u);
                const int id = utl[1024 + qi], qb = id & 31, bh = id >> 5, b = bh >> 3, h = bh & 7;
                const size_t rowb = (size_t)b * SEQ; const int q0 = qb * 256; const int NT = (q0 + 256) / 64;
                EpiMla E{(unsigned char*)MIX + (rowb + q0) * DM + 512 + h * 64, SSQM + (rowb + q0) * 8 + h};
                const bool bad = __builtin_amdgcn_readfirstlane((int)att2::unit<96, 1, false, 768, 768, 512, EpiMla, 0, false>(lds, QM + (rowb + q0) * 768 + h * 96, KM + rowb * 768 + h * 96, VM + rowb * 512 + h * 64, NT, q0, 0.f, 0.f, 0.f, E)) != 0 || (FORCE_RETRY && (id & 7) == 5);
                if (bad) { if (tid == 0) __hip_atomic_store(redo + 1024 + nredo_m, id, __ATOMIC_RELAXED, __HIP_MEMORY_SCOPE_AGENT); ++nredo_m; }
                if (tid == 0) qslot[0] = nxt;
                __syncthreads();
            }
        }
#endif
        asm volatile("s_waitcnt vmcnt(0)" ::: "memory"); __syncthreads();
#ifndef ATT_NO_DIFF
#pragma nounroll
        for (int k = 0; k < nredo_d; ++k) {
            const int id = __hip_atomic_load(redo + k, __ATOMIC_RELAXED, __HIP_MEMORY_SCOPE_AGENT), qb = id & 31, bh = id >> 5, b = bh >> 3, h = bh & 7;
            const size_t rowb = (size_t)b * SEQ; const int q0 = qb * 256; const int NT = (q0 + 256) / 64;
            const float km0 = sqrtf(__uint_as_float(__hip_atomic_load(ctl + CW_KMAX + b * 16 + h * 2, __ATOMIC_RELAXED, __HIP_MEMORY_SCOPE_AGENT))) * 1.02f;
            const float km1 = sqrtf(__uint_as_float(__hip_atomic_load(ctl + CW_KMAX + b * 16 + h * 2 + 1, __ATOMIC_RELAXED, __HIP_MEMORY_SCOPE_AGENT))) * 1.02f;
            EpiDiff E{(unsigned char*)MIX + (rowb + q0) * DM + h * 64, lam, diff_out_g};
            att2::unit<32, 2, true, 512, 512, 512, EpiDiff, 0, true>(lds, QD + (rowb + q0) * 512 + h * 64, KD + rowb * 512 + h * 64, VD + rowb * 512 + h * 64, NT, q0, LOG2E * __builtin_amdgcn_exp2f(-(float)(h + 1)), km0, km1, E);
            __syncthreads();
        }
#endif
#ifndef ATT_NO_MLA
#pragma nounroll
        for (int k = 0; k < nredo_m; ++k) {
            const int id = __hip_atomic_load(redo + 1024 + k, __ATOMIC_RELAXED, __HIP_MEMORY_SCOPE_AGENT), qb = id & 31, bh = id >> 5, b = bh >> 3, h = bh & 7;
            const size_t rowb = (size_t)b * SEQ; const int q0 = qb * 256; const int NT = (q0 + 256) / 64;
            EpiMla E{(unsigned char*)MIX + (rowb + q0) * DM + 512 + h * 64, SSQM + (rowb + q0) * 8 + h};
            att2::unit<96, 1, false, 768, 768, 512, EpiMla, 0, true>(lds, QM + (rowb + q0) * 768 + h * 96, KM + rowb * 768 + h * 96, VM + rowb * 512 + h * 64, NT, q0, 0.f, 0.f, 0.f, E);
            __syncthreads();
        }
#endif
#if PROBE_VAR >= 0
        for (int L = vcu; L < 1024; L += G) {
            const int round = L >> 8, slot = L & 255, bh = slot >> 3, s = slot & 7, b = bh >> 3, h = bh & 7, i = round & 3;
            const int qb = (i == 0) ? s : (i == 1) ? 15 - s : (i == 2) ? 16 + s : 31 - s;
            const size_t rowb = (size_t)b * SEQ; const int q0 = qb * 256; const int NT = (q0 + 256) / 64;
            EpiMla E{(unsigned char*)(ws + 400 * MiB) + (rowb + q0) * DM + 512 + h * 64, (float*)(ws + 470 * MiB) + (rowb + q0) * 8 + h};
            att2::unit<96, 1, false, 768, 768, 512, EpiMla, PROBE_VAR>(lds, QM + (rowb + q0) * 768 + h * 96, KM + rowb * 768 + h * 96, VM + rowb * 512 + h * 64, NT, q0, 0.f, 0.f, 0.f, E);
        }
#endif
    }
    SEAM(3);
    _Pragma("unroll") for (int rep_ = 0; rep_ < (((PROBE_PH >> 5) & 1) ? 2 : 1); ++rep_) if (IN(5)) {
        pg8::DenseOrder S; S.init(T, DM, G, bx, DM, W_OUT, DM, 1); pg8::EpiResid<false, 4, true> E{nullptr, XN, X1B, SSQ1, SSQM, nullptr, 1.f / (MIX_SC * 16.f), (const float*)(ws + WS_RS0)};
        pg8::gemm_phase<pg8::EpiResid<false, 4, true>, pg8::DenseOrder, true>(lds, (const char*)MIX, DM, DM, DM, S, E);
    }
    SEAM(5);
    _Pragma("unroll") for (int rep_ = 0; rep_ < (((PROBE_PH >> 6) & 1) ? 2 : 1); ++rep_) if (IN(6)) {
#define P67_BODY(L) do { \
            const int pm = (L) >> 1, pn = (L) & 1; \
            { pg8::OneUnit S{pm, pn, (const char*)W_MQ, DM, 2}; pg8::EpiCrossQ E{QC, SSQ1}; \
              pg8::gemm_phase<pg8::EpiCrossQ, pg8::OneUnit, true>(lds, (const char*)X1B, DM, DM, DM, S, E); } \
            asm volatile("s_waitcnt vmcnt(0)" ::: "memory"); __syncthreads(); \
            const int b = pm >> 5; const size_t row0 = (size_t)pm * 256; \
            int badm = 0; \
_Pragma("unroll 1") \
            for (int hh = 0; hh < 2; ++hh) { const int h = pn * 2 + hh; \
                EpiCross E{(unsigned char*)OC + row0 * 512 + h * 128}; \
                const bool bad_ = att::attn_unit<128, 1, 128, false, false, 512, 512, 512, EpiCross, true>(lds, QC + row0 * 512 + h * 128, KC + (size_t)b * NMEM * 512 + h * 128, VC + (size_t)b * NMEM * 512 + h * 128, NMEM / 64, 0, 0.f, E); \
                badm |= (__builtin_amdgcn_readfirstlane((int)bad_) != 0) ? (1 << hh) : 0; } \
_Pragma("unroll 1") \
            for (int hh = 0; hh < 2; ++hh) { if (!((badm >> hh) & 1)) continue; const int h = pn * 2 + hh;     \
                EpiCross E{(unsigned char*)OC + row0 * 512 + h * 128}; \
                att::attn_unit<128, 1, 128, false, false, 512, 512, 512, EpiCross, false>(lds, QC + row0 * 512 + h * 128, KC + (size_t)b * NMEM * 512 + h * 128, VC + (size_t)b * NMEM * 512 + h * 128, NMEM / 64, 0, 0.f, E); } \
        } while (0)
        if (vcu < 256) P67_BODY(vcu);
#undef P67_BODY
    }
    SEAM(7);
    _Pragma("unroll") for (int rep_ = 0; rep_ < (((PROBE_PH >> 8) & 1) ? 2 : 1); ++rep_) if (IN(8)) {
        pg8::DenseOrder S; S.init(T, DM, G, bx, 512, W_MO, 512, 1); pg8::EpiResid<false, 0, true> E{nullptr, X1B, X2B, SSQ2, nullptr, ws + WS_X2Q, 1.f / 128.f, nullptr};
        pg8::gemm_phase<pg8::EpiResid<false, 0, true>, pg8::DenseOrder, true>(lds, (const char*)OC, 512, 512, 512, S, E);
    }
    SEAM(8);
    if (IN(9)) {
        for (int i = tid; i < 2 * 36 * 128; i += 512) { const int rowi = i >> 7, ch = i & 127; *(LAS u32x4*)(lds + rowi * 2064 + ch * 16) = *(const u32x4*)(W_R + (size_t)rowi * DM + ch * 8); }
        __syncthreads();
        const int r32 = lane & 31, hi = lane >> 5;
        const int m1 = 32 + (r32 < 4 ? r32 : 3);
        LAS unsigned* lcnt = (LAS unsigned*)(lds + TP_OFF + 256); LAS unsigned* lbase = lcnt + 32;
        for (int tt0 = 0; tt0 < T / 32; tt0 += NGW) {
            const int tt = tt0 + wave * G + vcu; const bool act = tt < T / 32;
            if (tid < 32) lcnt[tid] = 0u;
            __syncthreads();
            int e1 = 0, e2 = 0; unsigned p1 = 0, p2 = 0; float w1 = 0.f, w2 = 0.f, rs_tok = 0.f; const int tok = tt * 32 + r32;
            if (act) {
                const bf16* xrow = X2B + (size_t)tok * DM + hi * 8;
                f32x16 a0, a1;
#pragma unroll
                for (int r = 0; r < 16; ++r) { a0[r] = 0.f; a1[r] = 0.f; }
                bf16x8 xa[16], xb[16];
#pragma unroll
                for (int j = 0; j < 16; ++j) xa[j] = *(const bf16x8*)(xrow + j * 16);
#pragma unroll 1
                for (int s0 = 0; s0 < 64; s0 += 16) {
                    if (s0 + 16 < 64) {
#pragma unroll
                        for (int j = 0; j < 16; ++j) xb[j] = *(const bf16x8*)(xrow + (s0 + 16 + j) * 16); }
#pragma unroll
                    for (int j = 0; j < 16; ++j) { const bf16x8 xf = xa[j];
                        const LAS unsigned char* wp = lds + (s0 + j) * 32 + hi * 16;
                        const bf16x8 w0h = *(const LAS bf16x8*)(wp + r32 * 2064), w0l = *(const LAS bf16x8*)(wp + (36 + r32) * 2064);
                        const bf16x8 w1h = *(const LAS bf16x8*)(wp + m1 * 2064), w1l = *(const LAS bf16x8*)(wp + (36 + m1) * 2064);
                        a0 = __builtin_amdgcn_mfma_f32_32x32x16_bf16(w0h, xf, a0, 0, 0, 0); a0 = __builtin_amdgcn_mfma_f32_32x32x16_bf16(w0l, xf, a0, 0, 0, 0);
                        a1 = __builtin_amdgcn_mfma_f32_32x32x16_bf16(w1h, xf, a1, 0, 0, 0); a1 = __builtin_amdgcn_mfma_f32_32x32x16_bf16(w1l, xf, a1, 0, 0, 0); }
#pragma unroll
                    for (int j = 0; j < 16; ++j) xa[j] = xb[j];
                }
                const f32x4* pp = (const f32x4*)(SSQ2 + (size_t)tok * 16); const f32x4 p = (pp[0] + pp[1]) + (pp[2] + pp[3]);
                const float rs = __builtin_amdgcn_rsqf(((p[0] + p[1]) + (p[2] + p[3])) * (1.f / 1024.f) + EPS); rs_tok = rs;
                float gl[4];
#pragma unroll
                for (int g = 0; g < 4; ++g) { const float mine = a1[g]; const float other = __shfl_xor(mine, 32); gl[g] = (hi == 0 ? mine : other) * rs + b_group_router[g]; }
                int gs = 0; float gm = gl[0];
#pragma unroll
                for (int g = 1; g < 4; ++g) if (gl[g] > gm) { gm = gl[g]; gs = g; }
                float gden = 0.f;
#pragma unroll
                for (int g = 0; g < 4; ++g) gden += __expf(gl[g] - gm);
                const float ggate = 1.f / gden;
                float mine4[4];
#pragma unroll
                for (int j = 0; j < 4; ++j) { const float v = (gs == 0) ? a0[j] : (gs == 1) ? a0[4 + j] : (gs == 2) ? a0[8 + j] : a0[12 + j]; mine4[j] = v * rs + b_expert_router[8 * gs + 4 * hi + j]; }
                float v8[8];
#pragma unroll
                for (int j = 0; j < 4; ++j) { const float o = __shfl_xor(mine4[j], 32); v8[j] = hi == 0 ? mine4[j] : o; v8[4 + j] = hi == 0 ? o : mine4[j]; }
                int i1 = 0; float b1 = v8[0];
#pragma unroll
                for (int j = 1; j < 8; ++j) if (v8[j] > b1) { b1 = v8[j]; i1 = j; }
                int i2 = -1; float b2 = -INFINITY;
#pragma unroll
                for (int j = 0; j < 8; ++j) if (j != i1 && v8[j] > b2) { b2 = v8[j]; i2 = j; }
                const float dd = __expf(b2 - b1); w1 = ggate / (1.f + dd); w2 = w1 * dd;
                e1 = 8 * gs + i1; e2 = 8 * gs + i2;
                if (hi == 0) { RS2[tok] = rs; p1 = atomicAdd((unsigned*)(lds_raw + TP_OFF + 256) + e1, 1u); p2 = atomicAdd((unsigned*)(lds_raw + TP_OFF + 256) + e2, 1u); }
            }
            __syncthreads();
            if (tid < 32) { const unsigned c = lcnt[tid]; lbase[tid] = c ? atomicAdd(CNT + 64 * tid, c) : 0u; }
            __syncthreads();
            if (act && hi == 0) {
                ((float*)(ws + WS_RSL))[(size_t)e1 * T + lbase[e1] + p1] = rs_tok; ((float*)(ws + WS_RSL))[(size_t)e2 * T + lbase[e2] + p2] = rs_tok;
                LIST[(size_t)e1 * T + lbase[e1] + p1] = 2 * tok; WTS[2 * tok] = w1; ((int*)(ws + WS_POS))[2 * tok] = (e1 << 16) | (int)(lbase[e1] + p1);
                LIST[(size_t)e2 * T + lbase[e2] + p2] = 2 * tok + 1; WTS[2 * tok + 1] = w2; ((int*)(ws + WS_POS))[2 * tok + 1] = (e2 << 16) | (int)(lbase[e2] + p2);
            }
            __syncthreads();
        }
    }
    SEAM(9);
    if (IN(10) || IN(11) || IN(12)) {
        if (wave == 0) {
            const int c_ = (lane < NEXP) ? (int)__hip_atomic_load(CNT + 64 * lane, __ATOMIC_RELAXED, __HIP_MEMORY_SCOPE_AGENT) : 0; const int t_ = (c_ + 255) >> 8; int s_ = t_;
#pragma unroll
            for (int o = 1; o < 32; o <<= 1) { const int u_ = __shfl_up(s_, o); if (lane >= o) s_ += u_; }
            if (lane < NEXP) { TP[lane] = s_ - t_; TP[128 + lane] = c_; }
            if (lane == NEXP - 1) TP[NEXP] = s_; }
        __syncthreads();
    }
    _Pragma("unroll") for (int rep_ = 0; rep_ < (((PROBE_PH >> 10) & 1) ? 2 : 1); ++rep_) if (IN(10)) {
        pg8::MoeOrder<true> S{G, vcu, 2, DM, (const char*)W_GU, DM, (size_t)512 * DM, TP, CNT, LIST, 1};
        pg8::EpiMoeUp E{HB, LIST, (const float*)(ws + WS_RSL), TP};
        pg8::gemm_phase<pg8::EpiMoeUp, pg8::MoeOrder<true>, true>(lds, (const char*)(ws + WS_X2Q), DM, DM, DM, S, E);
    }
    SEAM(10);
    _Pragma("unroll") for (int rep_ = 0; rep_ < (((PROBE_PH >> 11) & 1) ? 2 : 1); ++rep_) if (IN(11)) {
        pg8::MoeOrder<false> S{G, vcu, 4, EFF, (const char*)W_DN, EFF, (size_t)1024 * EFF, TP, CNT, LIST, 1};
        pg8::EpiMoeDown E{YB};
        pg8::gemm_phase<pg8::EpiMoeDown, pg8::MoeOrder<false>, true>(lds, (const char*)HB, EFF, EFF, EFF, S, E);
    }
    SEAM(11);
    _Pragma("unroll") for (int rep_ = 0; rep_ < (((PROBE_PH >> 12) & 1) ? 2 : 1); ++rep_) if (IN(12)) {
        f32x4 gq[4];
#pragma unroll
        for (int q = 0; q < 4; ++q) gq[q] = *(const f32x4*)(norm_final_g + 4 * lane + 256 * q);
        for (int m0 = gw * 4; m0 < T; m0 += NGW * 4) {
            u32x2 a[4][4]; unsigned b[4][4], c[4][4]; float wa[4], wb[4];
#pragma unroll
            for (int r = 0; r < 4; ++r) { const int m = m0 + r;
                const int pa = ((const int*)(ws + WS_POS))[2 * m], pb = ((const int*)(ws + WS_POS))[2 * m + 1];
                const size_t sa = (size_t)TP[pa >> 16] * 256 + (pa & 0xffff), sb = (size_t)TP[pb >> 16] * 256 + (pb & 0xffff);
                wa[r] = WTS[2 * m]; wb[r] = WTS[2 * m + 1];
                const u32x2* xp = (const u32x2*)(X2B + (size_t)m * DM); const unsigned* y0 = (const unsigned*)((const unsigned char*)YB + sa * DM); const unsigned* y1 = (const unsigned*)((const unsigned char*)YB + sb * DM);
#pragma unroll
                for (int q = 0; q < 4; ++q) { a[r][q] = xp[lane + 64 * q]; b[r][q] = y0[lane + 64 * q]; c[r][q] = y1[lane + 64 * q]; } }
#pragma unroll
            for (int r = 0; r < 4; ++r) { const int m = m0 + r; f32x4 v[4]; float s = 0.f;
#pragma unroll
                for (int q = 0; q < 4; ++q) { const f32x2 yb0 = __builtin_amdgcn_cvt_pk_f32_fp8(b[r][q], false), yb1 = __builtin_amdgcn_cvt_pk_f32_fp8(b[r][q], true), yc0 = __builtin_amdgcn_cvt_pk_f32_fp8(c[r][q], false), yc1 = __builtin_amdgcn_cvt_pk_f32_fp8(c[r][q], true);
                    const unsigned xa = a[r][q].x, xb = a[r][q].y;
                    v[q][0] = bf_lo(xa) + wa[r] * yb0[0] + wb[r] * yc0[0]; v[q][1] = bf_hi(xa) + wa[r] * yb0[1] + wb[r] * yc0[1];
                    v[q][2] = bf_lo(xb) + wa[r] * yb1[0] + wb[r] * yc1[0]; v[q][3] = bf_hi(xb) + wa[r] * yb1[1] + wb[r] * yc1[1];
                    s += (v[q][0] * v[q][0] + v[q][1] * v[q][1]) + (v[q][2] * v[q][2] + v[q][3] * v[q][3]); }
                const float rs = __builtin_amdgcn_rsqf(wave_sum(s) * (1.f / DM) + EPS);
                float* orow = (float*)KARG(30) + (size_t)m * DM;
#pragma unroll
                for (int q = 0; q < 4; ++q) __builtin_nontemporal_store(v[q] * rs * gq[q], (f32x4*)(orow + 4 * lane + 256 * q)); }
        }
    }
#undef P0_DECODE
#undef IN
#undef SEAM
#undef KARG
#undef ws
#undef ctl
#undef CNT
#undef W_IN
#undef W_UQ
#undef W_UKV
#undef W_OUT
#undef W_MQ
#undef W_MKV
#undef W_MO
#undef W_R
#undef W_GU
#undef W_DN
#undef RCOS
#undef SSQM
#undef SSQ1
#undef SSQ2
#undef SSQQ
#undef SSQKV
#undef KC
#undef VC
#undef MEMN
#undef WTS
#undef RS2
#undef MISCF
#undef LIST
#undef XN
#undef MIX
#undef HB
#undef QD
#undef KD
#undef VD
#undef X1B
#undef QC
#undef CQ
#undef CKV
#undef QM
#undef KM
#undef VM
#undef X2B
#undef OC
#undef YB
#undef RSIN
#undef xin
#undef mem
#undef positions
#undef norm_mix_g
#undef w_in
#undef lq1
#undef lk1
#undef lq2
#undef lk2
#undef diff_out_g
#undef mla_q_norm_g
#undef w_mla_uq
#undef mla_kv_norm_g
#undef w_mla_ukv
#undef mla_out_g
#undef w_out
#undef norm_cross_g
#undef norm_mem_g
#undef w_mem_q
#undef w_mem_kv
#undef w_mem_o
#undef norm_ffn_g
#undef w_group_router
#undef b_group_router
#undef w_expert_router
#undef b_expert_router
#undef w_expert_gate
#undef w_expert_up
#undef w_expert_down
#undef norm_final_g
}

extern "C" void kernel_launch(void* const* d_in, const int* in_sizes, int n_in, void* d_out, int out_size, void* d_ws, size_t ws_size, hipStream_t stream) {
    static int grid = 0;
    if (grid == 0) {
        if (n_in != 30 || out_size != T * DM || ws_size < WS_END) { fprintf(stderr, "kernel_launch: unexpected shapes (n_in %d, out %d, ws %zu)\n", n_in, out_size, ws_size); grid = -1; return; }
        int dev = 0, cus = 0, per_cu = 0;
        if (hipGetDevice(&dev) != hipSuccess || hipDeviceGetAttribute(&cus, hipDeviceAttributeMultiprocessorCount, dev) != hipSuccess) { grid = -1; return; }
        if (hipFuncSetAttribute((const void*)mega_fwd, hipFuncAttributeMaxDynamicSharedMemorySize, LDS_BYTES) != hipSuccess) { fprintf(stderr, "kernel_launch: hipFuncSetAttribute failed\n"); grid = -1; return; }
        if (hipOccupancyMaxActiveBlocksPerMultiprocessor(&per_cu, (const void*)mega_fwd, NWAVES * 64, LDS_BYTES) != hipSuccess || per_cu < 1) { fprintf(stderr, "kernel_launch: occupancy query reports %d\n", per_cu); }
        (void)hipGetLastError();
        if (cus < 256) { fprintf(stderr, "kernel_launch: built for a 256-CU MI355X (got %d CUs)\n", cus); grid = -1; return; }
        grid = cus;
    }
    if (grid < 0) return;
    if (hipMemsetAsync((char*)d_ws + WS_CTL, 0, CTL_ZERO_BYTES, stream) != hipSuccess) return;
    Args a{};
    for (int i = 0; i < 30; ++i) a.in[i] = d_in[i];
    a.out = (float*)d_out; a.ws = (unsigned char*)d_ws; a.reps = PROBE_PH; a.pad_ = 0;
#if MK_N_LAUNCHES == 1
    a.ph_lo = 0; a.ph_hi = N_PHASES;
    hipLaunchKernelGGL(mega_fwd, dim3(grid), dim3(NWAVES * 64), LDS_BYTES, stream, a);
#else
    for (int p = 0; p < N_PHASES; ++p) { a.ph_lo = p; a.ph_hi = p + 1; hipLaunchKernelGGL(mega_fwd, dim3(grid), dim3(NWAVES * 64), LDS_BYTES, stream, a); }
#endif
}
```
